# Optimizing an MI355X kernel written in HIP

```python
import jax, jax.numpy as jnp
from jax import lax
import numpy as np

D_MODEL = 1024
BATCH = 8
SEQ = 2048
DEPTH = 1

GRID_W = 64
CTX_LEN = 256
HEAD_DIM = 64
A_HEADS = 8
A_KV_HEADS = 2
A_WINDOW = 128
A_BLOCK = 128
B_HEADS = 8
B_WIN_ROWS = 8
B_WIN_COLS = 16
N_EXPERTS = 32
TOP_K = 4
D_EXPERT = D_MODEL
SWIGLU_LIMIT = 7.0
SWIGLU_ALPHA = 1.702
ROPE_THETA = 10000.0
NORM_EPS = 1e-6
MOE_BLOCK = 128
A_Q = A_HEADS * HEAD_DIM
A_KV = A_KV_HEADS * HEAD_DIM
B_W = B_HEADS * HEAD_DIM
IN_COLS = A_Q + 2 * A_KV + 3 * B_W + 2 * D_MODEL

kernel_name = "hybrid_dit_window_natten_moe"


def rms_norm(x, g):
    xf = x.astype(jnp.float32)
    y = xf * lax.rsqrt(jnp.mean(xf * xf, axis=-1, keepdims=True) + NORM_EPS)
    return (y * g.astype(jnp.float32)).astype(x.dtype)


def modulate(h, shift, scale):
    return h * (1 + scale) + shift


def softmax_with_sink(s, sink):
    if sink is None:
        return jax.nn.softmax(s, axis=-1)
    sink = sink.astype(jnp.float32)
    m = jnp.maximum(jnp.max(s, axis=-1, keepdims=True), sink)
    e = jnp.exp(s - m)
    return e / (jnp.sum(e, axis=-1, keepdims=True) + jnp.exp(sink - m))


def axial_rope_tables(n_tokens):
    t = jnp.arange(n_tokens, dtype=jnp.int32)
    row = (t // GRID_W).astype(jnp.float32)
    col = (t % GRID_W).astype(jnp.float32)
    n_freq = HEAD_DIM // 4
    inv_freq = ROPE_THETA ** (-jnp.arange(n_freq, dtype=jnp.float32) / n_freq)
    ang = jnp.concatenate([row[:, None] * inv_freq, col[:, None] * inv_freq], axis=-1)
    return jnp.cos(ang), jnp.sin(ang)


def apply_axial_rope(x, cos, sin):
    b, s, h, d = x.shape
    nf = HEAD_DIM // 4
    xr = x.reshape(b, s, h, 2, 2, nf)
    x1, x2 = xr[..., 0, :], xr[..., 1, :]
    c = cos.reshape(s, 1, 2, nf).astype(x.dtype)
    sn = sin.reshape(s, 1, 2, nf).astype(x.dtype)
    out = jnp.stack([x1 * c - x2 * sn, x2 * c + x1 * sn], axis=-2)
    return out.reshape(b, s, h, d)


def split_projection(p):
    bounds = [A_Q, A_Q + A_KV, A_Q + 2 * A_KV, A_Q + 2 * A_KV + B_W,
              A_Q + 2 * A_KV + 2 * B_W, A_Q + 2 * A_KV + 3 * B_W,
              A_Q + 2 * A_KV + 3 * B_W + D_MODEL]
    qa, ka, va, qb, kb, vb, ga, gb = jnp.split(p, bounds, axis=-1)
    heads = lambda t, n: t.reshape(*t.shape[:-1], n, HEAD_DIM)
    return (heads(qa, A_HEADS), heads(ka, A_KV_HEADS), heads(va, A_KV_HEADS),
            heads(qb, B_HEADS), heads(kb, B_HEADS), heads(vb, B_HEADS), ga, gb)


def windowed_sink_attention(q, k, v, k_ctx, v_ctx, sink):
    b, s, _, hd = q.shape
    nb = s // A_BLOCK
    g = A_HEADS // A_KV_HEADS
    scale = HEAD_DIM ** -0.5
    qb = q.reshape(b, nb, A_BLOCK, A_KV_HEADS, g, hd)
    pad = ((0, 0), (A_BLOCK, A_BLOCK), (0, 0), (0, 0))
    kp = jnp.pad(k, pad).reshape(b, nb + 2, A_BLOCK, A_KV_HEADS, hd)
    vp = jnp.pad(v, pad).reshape(b, nb + 2, A_BLOCK, A_KV_HEADS, hd)
    kb = jnp.concatenate([kp[:, :-2], kp[:, 1:-1], kp[:, 2:]], axis=2)
    vb = jnp.concatenate([vp[:, :-2], vp[:, 1:-1], vp[:, 2:]], axis=2)
    s_loc = jnp.einsum('bnqkgd,bnjkd->bnkgqj', qb, kb).astype(jnp.float32) * scale
    qpos = jnp.arange(nb)[:, None] * A_BLOCK + jnp.arange(A_BLOCK)[None, :]
    kpos = jnp.arange(nb)[:, None] * A_BLOCK - A_BLOCK + jnp.arange(3 * A_BLOCK)[None, :]
    valid = ((jnp.abs(qpos[:, :, None] - kpos[:, None, :]) <= A_WINDOW)
             & (kpos >= 0)[:, None, :] & (kpos < s)[:, None, :])
    s_loc = jnp.where(valid[None, :, None, None], s_loc, -jnp.inf)
    s_ctx = jnp.einsum('bnqkgd,bckd->bnkgqc', qb, k_ctx).astype(jnp.float32) * scale
    n_loc = s_loc.shape[-1]
    p = softmax_with_sink(jnp.concatenate([s_loc, s_ctx], axis=-1),
                          sink.reshape(A_KV_HEADS, g)[None, None, :, :, None, None])
    p = p.astype(v.dtype)
    o = (jnp.einsum('bnkgqj,bnjkd->bnqkgd', p[..., :n_loc], vb)
         + jnp.einsum('bnkgqc,bckd->bnqkgd', p[..., n_loc:], v_ctx))
    return o.reshape(b, s, A_Q)


def neighbourhood_attention(q, k, v, k_ctx, v_ctx, rpb):
    b, s, h, hd = q.shape
    rows = s // GRID_W
    kr = min(B_WIN_ROWS, rows)
    kc = B_WIN_COLS
    scale = HEAD_DIM ** -0.5
    r = jnp.arange(rows)
    cidx = jnp.arange(GRID_W)
    row_start = jnp.clip(r - kr // 2, 0, rows - kr)
    row_idx = row_start[:, None] + jnp.arange(kr)[None, :]
    col_start = jnp.clip(cidx - kc // 2, 0, GRID_W - kc)
    col_in = (cidx[None, :] >= col_start[:, None]) & (cidx[None, :] < col_start[:, None] + kc)
    qg = q.reshape(b, rows, GRID_W, h, hd)
    kg = k.reshape(b, rows, GRID_W, h, hd)[:, row_idx]
    vg = v.reshape(b, rows, GRID_W, h, hd)[:, row_idx]
    s_loc = jnp.einsum('brqhd,brkwhd->bhrqkw', qg, kg).astype(jnp.float32) * scale
    roff = row_idx - r[:, None] + (B_WIN_ROWS - 1)
    coff = jnp.clip(cidx[None, :] - cidx[:, None], -(kc - 1), kc - 1) + (B_WIN_COLS - 1)
    bias = rpb[:, roff[:, None, :, None], coff[None, :, None, :]]
    s_loc = jnp.where(col_in[None, None, None, :, None, :], s_loc + bias[None].astype(jnp.float32), -jnp.inf)
    s_loc = s_loc.reshape(b, h, rows, GRID_W, kr * GRID_W)
    s_ctx = jnp.einsum('brqhd,bchd->bhrqc', qg, k_ctx).astype(jnp.float32) * scale
    n_loc = kr * GRID_W
    p = jax.nn.softmax(jnp.concatenate([s_loc, s_ctx], axis=-1), axis=-1).astype(v.dtype)
    p_loc = p[..., :n_loc].reshape(b, h, rows, GRID_W, kr, GRID_W)
    o = (jnp.einsum('bhrqkw,brkwhd->brqhd', p_loc, vg)
         + jnp.einsum('bhrqc,bchd->brqhd', p[..., n_loc:], v_ctx))
    return o.reshape(b, s, B_W)


def dense_context_attention(q, k, v, sink):
    b, c, h, hd = q.shape
    n_kv = k.shape[2]
    g = h // n_kv
    qg = q.reshape(b, c, n_kv, g, hd)
    s = jnp.einsum('bqkgd,bckd->bkgqc', qg, k).astype(jnp.float32) * (HEAD_DIM ** -0.5)
    snk = None if sink is None else sink.reshape(n_kv, g)[None, :, :, None, None]
    p = softmax_with_sink(s, snk).astype(v.dtype)
    o = jnp.einsum('bkgqc,bckd->bqkgd', p, v)
    return o.reshape(b, c, h * hd)


def merge_branches(ya, yb, ga, gb, w_branch_a, w_branch_b, w_out):
    merged = jax.nn.sigmoid(ga) * (ya @ w_branch_a) + jax.nn.sigmoid(gb) * (yb @ w_branch_b)
    return merged @ w_out


def moe_ffn(h, w_router, b_router, w_gate_up, b_gate_up, w_down, b_down):
    shp = h.shape
    xt = h.reshape(-1, D_MODEL)
    t = xt.shape[0]
    logits = (xt @ w_router + b_router).astype(jnp.float32)
    top_val, top_idx = lax.top_k(logits, TOP_K)
    weights = jax.nn.softmax(top_val, axis=-1)
    n_assign = t * TOP_K
    expert = top_idx.reshape(-1)
    token = jnp.arange(n_assign, dtype=jnp.int32) // TOP_K
    order = jnp.argsort(expert)
    sorted_expert = expert[order]
    sorted_token = token[order]
    counts = jnp.bincount(expert, length=N_EXPERTS)
    padded = ((counts + MOE_BLOCK - 1) // MOE_BLOCK) * MOE_BLOCK
    start = jnp.cumsum(counts) - counts
    pend = jnp.cumsum(padded)
    pstart = pend - padded
    dest = pstart[sorted_expert] + (jnp.arange(n_assign) - start[sorted_expert])
    n_blocks = -(-n_assign // MOE_BLOCK) + N_EXPERTS
    x_pad = jnp.zeros((n_blocks * MOE_BLOCK, D_MODEL), xt.dtype).at[dest].set(xt[sorted_token])
    block_expert = jnp.clip(jnp.searchsorted(pend, jnp.arange(n_blocks) * MOE_BLOCK, side='right'),
                            0, N_EXPERTS - 1)

    def expert_block(args):
        xb, e = args
        gu = xb @ w_gate_up[e] + b_gate_up[e]
        gate, up = jnp.split(gu, 2, axis=-1)
        gate = jnp.minimum(gate, SWIGLU_LIMIT)
        up = jnp.clip(up, -SWIGLU_LIMIT, SWIGLU_LIMIT)
        glu = gate * jax.nn.sigmoid(SWIGLU_ALPHA * gate)
        return ((up + 1) * glu) @ w_down[e] + b_down[e]

    y_pad = lax.map(expert_block, (x_pad.reshape(n_blocks, MOE_BLOCK, D_MODEL), block_expert))
    y_sorted = y_pad.reshape(-1, D_MODEL)[dest] * weights.reshape(-1)[order][:, None].astype(xt.dtype)
    y = jax.ops.segment_sum(y_sorted, sorted_token, num_segments=t)
    return y.reshape(shp)


def setup_inputs(seed: int = 0) -> dict:
    key = jax.random.key(seed)
    ks = jax.random.split(key, 24)
    f = jnp.float32
    L = DEPTH

    def nrm(k, shape, scale):
        return jax.random.normal(k, shape, f) * scale

    return {
        "x": nrm(ks[0], (BATCH, SEQ, D_MODEL), 1.0),
        "c": nrm(ks[1], (BATCH, D_MODEL), 1.0),
        "ctx": nrm(ks[2], (BATCH, CTX_LEN, D_MODEL), 1.0),
        "c_ctx": nrm(ks[3], (D_MODEL,), 1.0),
        "w_mod": nrm(ks[4], (L, D_MODEL, 6 * D_MODEL), 0.3 * D_MODEL ** -0.5),
        "b_mod": nrm(ks[5], (L, 6 * D_MODEL), 0.02),
        "g_pre_mix": 1.0 + nrm(ks[6], (L, D_MODEL), 0.05),
        "g_post_mix": 1.0 + nrm(ks[7], (L, D_MODEL), 0.05),
        "g_pre_ffn": 1.0 + nrm(ks[8], (L, D_MODEL), 0.05),
        "g_post_ffn": 1.0 + nrm(ks[9], (L, D_MODEL), 0.05),
        "w_in": nrm(ks[10], (L, D_MODEL, IN_COLS), D_MODEL ** -0.5),
        "a_sink": nrm(ks[11], (L, A_HEADS), 0.5),
        "b_rpb": nrm(ks[12], (L, B_HEADS, 2 * B_WIN_ROWS - 1, 2 * B_WIN_COLS - 1), 0.2),
        "w_branch_a": nrm(ks[13], (L, A_Q, D_MODEL), A_Q ** -0.5),
        "w_branch_b": nrm(ks[14], (L, B_W, D_MODEL), B_W ** -0.5),
        "w_out": nrm(ks[15], (L, D_MODEL, D_MODEL), D_MODEL ** -0.5),
        "w_router": nrm(ks[16], (L, D_MODEL, N_EXPERTS), D_MODEL ** -0.5),
        "b_router": nrm(ks[17], (L, N_EXPERTS), 0.01),
        "w_gate_up": nrm(ks[18], (L, N_EXPERTS, D_MODEL, 2 * D_EXPERT), D_MODEL ** -0.5),
        "b_gate_up": nrm(ks[19], (L, N_EXPERTS, 2 * D_EXPERT), 0.02),
        "w_down": nrm(ks[20], (L, N_EXPERTS, D_EXPERT, D_MODEL), D_EXPERT ** -0.5),
        "b_down": nrm(ks[21], (L, N_EXPERTS, D_MODEL), 0.02),
    }


def reference(x, c, ctx, c_ctx, w_mod, b_mod, g_pre_mix, g_post_mix, g_pre_ffn, g_post_ffn,
              w_in, a_sink, b_rpb, w_branch_a, w_branch_b, w_out, w_router, b_router,
              w_gate_up, b_gate_up, w_down, b_down):
    cos, sin = axial_rope_tables(x.shape[1])
    for l in range(DEPTH):
        mod_x = (jax.nn.silu(c) @ w_mod[l] + b_mod[l])[:, None, :]
        mod_c = (jax.nn.silu(c_ctx) @ w_mod[l] + b_mod[l])[None, None, :]
        sh1, sc1, g1, sh2, sc2, g2 = jnp.split(mod_x, 6, axis=-1)
        csh1, csc1, cg1, csh2, csc2, cg2 = jnp.split(mod_c, 6, axis=-1)

        hx = modulate(rms_norm(x, g_pre_mix[l]), sh1, sc1)
        hc = modulate(rms_norm(ctx, g_pre_mix[l]), csh1, csc1)
        qa, ka, va, qb, kb, vb, ga, gb = split_projection(hx @ w_in[l])
        cqa, cka, cva, cqb, ckb, cvb, cga, cgb = split_projection(hc @ w_in[l])
        qa = apply_axial_rope(qa, cos, sin)
        ka = apply_axial_rope(ka, cos, sin)
        ya = windowed_sink_attention(qa, ka, va, cka, cva, a_sink[l])
        yb = neighbourhood_attention(qb, kb, vb, ckb, cvb, b_rpb[l])
        mix = merge_branches(ya, yb, ga, gb, w_branch_a[l], w_branch_b[l], w_out[l])
        x = x + g1 * rms_norm(mix, g_post_mix[l])

        hx2 = modulate(rms_norm(x, g_pre_ffn[l]), sh2, sc2)
        ffn = moe_ffn(hx2, w_router[l], b_router[l], w_gate_up[l], b_gate_up[l], w_down[l], b_down[l])
        x = x + g2 * rms_norm(ffn, g_post_ffn[l])

        if l < DEPTH - 1:
            cya = dense_context_attention(cqa, cka, cva, a_sink[l])
            cyb = dense_context_attention(cqb, ckb, cvb, None)
            cmix = merge_branches(cya, cyb, cga, cgb, w_branch_a[l], w_branch_b[l], w_out[l])
            ctx = ctx + cg1 * rms_norm(cmix, g_post_mix[l])
            hc2 = modulate(rms_norm(ctx, g_pre_ffn[l]), csh2, csc2)
            cffn = moe_ffn(hc2, w_router[l], b_router[l], w_gate_up[l], b_gate_up[l], w_down[l], b_down[l])
            ctx = ctx + cg2 * rms_norm(cffn, g_post_ffn[l])
    return x
```

```cpp
#include <hip/hip_runtime.h>
#include <cstdio>
#include <cstdint>

#ifndef MK_N_LAUNCHES
#define MK_N_LAUNCHES 1
#endif

#define GAS __attribute__((address_space(1)))
#define LAS __attribute__((address_space(3)))
typedef unsigned short bf16;
typedef short bf16x8 __attribute__((ext_vector_type(8)));
typedef float f32x4 __attribute__((ext_vector_type(4)));
typedef unsigned u32x4 __attribute__((ext_vector_type(4)));
typedef unsigned u32x2 __attribute__((ext_vector_type(2)));
typedef GAS unsigned gu32;

constexpr int DM = 1024, NB = 8, SEQ = 2048, CTXL = 256, HD = 64;
constexpr int MT = NB * SEQ;
constexpr int MC = NB * CTXL;
constexpr int MA = MT + MC;
constexpr int INC = 4352;
constexpr int C_QA = 0, C_KA = 512, C_VA = 640, C_QB = 768, C_KB = 1280, C_VB = 1792, C_GA = 2304, C_GB = 3328;
constexpr int NE = 32, TOPK = 4, DE = 1024;
constexpr int SLOTS = MT * TOPK + NE * 256;
constexpr float NORM_EPS = 1e-6f;
constexpr int NWAVES = 8, NTHREADS = 512;
constexpr int PER_PHASE = 10;

constexpr size_t MiB = 1u << 20;
constexpr size_t WS_CTL = 0, CTL_ZERO_BYTES = 1 * MiB;
constexpr size_t WS_MODX = 1 * MiB;
constexpr size_t WS_MODC = WS_MODX + 8 * 6144 * 4;
constexpr size_t WS_ROPE = WS_MODC + 6144 * 4;
constexpr size_t WS_WIN = 2 * MiB;
constexpr size_t WS_WA = 11 * MiB;
constexpr size_t WS_WB = 12 * MiB;
constexpr size_t WS_WOUT = 13 * MiB;
constexpr size_t WS_TOPE = 15 * MiB;
constexpr size_t WS_TOPP = WS_TOPE + 256 * 1024;
constexpr size_t WS_TOPW = WS_TOPP + 256 * 1024;
constexpr size_t WS_WGU = 16 * MiB;
constexpr size_t WS_WD = 144 * MiB;
constexpr size_t WS_XN = 208 * MiB;
constexpr size_t WS_P = 244 * MiB;
constexpr size_t WS_ACT = WS_P;
constexpr size_t WS_YAB = 397 * MiB;
constexpr size_t WS_MERGED = 429 * MiB;
constexpr size_t WS_MIX = 461 * MiB;
constexpr size_t WS_TOK = 493 * MiB;
constexpr size_t WS_Y = 496 * MiB;
constexpr size_t WS_END = 640 * MiB;
static_assert(WS_ACT + (size_t)SLOTS * 1024 * 2 <= WS_YAB + 0 * MiB + 32 * MiB, "ACT overlays P (and may run into YAB, dead by then)");
static_assert(WS_Y + (size_t)SLOTS * 1024 * 2 <= WS_END, "ws map");
constexpr int CW_BAR = 4096;
constexpr int CW_CNT = 16384;

constexpr int LDS_BYTES = 147456;
constexpr int MISC_OFF = 131072 + 320;

#define RLX_AGENT __ATOMIC_RELAXED, __HIP_MEMORY_SCOPE_AGENT
__device__ __forceinline__ unsigned f2bf(float f) { unsigned u = __builtin_bit_cast(unsigned, f); return (u + 0x7fffu + ((u >> 16) & 1u)) >> 16; }
__device__ __forceinline__ unsigned pk2(float lo, float hi) { return f2bf(lo) | (f2bf(hi) << 16); }
__device__ __forceinline__ float bf2f(unsigned b) { return __builtin_bit_cast(float, b << 16); }
__device__ __forceinline__ float wave_sum(float v) {
#pragma unroll
    for (int o = 1; o < 64; o <<= 1) v += __shfl_xor(v, o);
    return v;
}
__device__ __forceinline__ float sigmoidf_(float x) { return 1.f / (1.f + __expf(-x)); }

#define XB_TMO      128
#define XB_XCNT(j)  (256  + 64 * (j))
#define XB_XSUB(j)  (1280 + 64 * (j))
#define XB_XGEN(j)  (2304 + 64 * (j))
#define XB_TOP      3328
#define XB_TOPGEN   3392
#define XCD_BAR_WORDS 3456
#define XB_SPIN_CAP (1u << 18)
__device__ __forceinline__ unsigned xb_ld(unsigned* p)              { return __hip_atomic_load(p, __ATOMIC_RELAXED, __HIP_MEMORY_SCOPE_AGENT); }
__device__ __forceinline__ unsigned xb_add(unsigned* p, unsigned v) { return __hip_atomic_fetch_add(p, v, __ATOMIC_RELAXED, __HIP_MEMORY_SCOPE_AGENT); }
__device__ __forceinline__ unsigned xb_xcc_id() { return (unsigned)__builtin_amdgcn_s_getreg((3 << 11) | 20) & 0xFu; }
#define XB_SPIN(cond, bar) do { unsigned _sp = 0; while (cond) { __builtin_amdgcn_s_sleep(1); \
    if ((++_sp & 255u) == 0u) { if (xb_ld(&(bar)[XB_TMO])) break; if (_sp > XB_SPIN_CAP) { atomicAdd(&(bar)[XB_TMO], 1u); break; } } } } while (0)
struct XcdBarrier { unsigned* bar; unsigned x; volatile LAS unsigned* st; };
__device__ __forceinline__ XcdBarrier xcd_barrier_post(unsigned* bar, volatile LAS unsigned* st) {
    XcdBarrier b; b.bar = bar; b.x = xb_xcc_id(); b.st = st;
    if (threadIdx.x == 0) (void)xb_add(&bar[XB_XCNT(b.x)], 1u);
    return b;
}
__device__ __forceinline__ void xcd_barrier_complete(unsigned* bar, unsigned x, unsigned& nloc, unsigned& nx) {
    const unsigned G = gridDim.x * gridDim.y * gridDim.z;
    unsigned sum, cnt, mine, sp = 0u;
    for (;;) {
        sum = 0u; cnt = 0u; mine = 0u;
#pragma unroll
        for (unsigned j = 0; j < 16; ++j) { const unsigned c = xb_ld(&bar[XB_XCNT(j)]); sum += c; cnt += (c > 0u) ? 1u : 0u; mine = (j == x) ? c : mine; }
        if (sum == G) break;
        __builtin_amdgcn_s_sleep(1);
        if ((++sp & 255u) == 0u) { if (xb_ld(&bar[XB_TMO])) break; if (sp > XB_SPIN_CAP) { atomicAdd(&bar[XB_TMO], 1u); break; } }
    }
    nloc = mine > 0u ? mine : 1u; nx = cnt > 0u ? cnt : 1u;
}
__device__ __forceinline__ void xcd_barrier(const XcdBarrier& b) {
    asm volatile("s_waitcnt vmcnt(0)" ::: "memory");
    __syncthreads();
    if (threadIdx.x == 0) {
        unsigned* bar = b.bar;
        __builtin_amdgcn_s_waitcnt(0);
        unsigned nloc = b.st[0], nx = b.st[1];
        if (nloc == 0u) { xcd_barrier_complete(bar, b.x, nloc, nx); b.st[0] = nloc; b.st[1] = nx; }
        const unsigned old = xb_add(&bar[XB_XSUB(b.x)], 1u);
        const unsigned gen = old / nloc;
        if (old + 1u == (gen + 1u) * nloc) {
            __builtin_amdgcn_fence(__ATOMIC_RELEASE, "agent");
            asm volatile("s_waitcnt vmcnt(0)" ::: "memory");
            const unsigned og = xb_add(&bar[XB_TOP], 1u);
            const unsigned tg = og / nx;
            if (og + 1u == (tg + 1u) * nx) xb_add(&bar[XB_TOPGEN], 1u);
            else XB_SPIN(xb_ld(&bar[XB_TOPGEN]) == tg, bar);
            __builtin_amdgcn_fence(__ATOMIC_ACQUIRE, "agent");
            xb_add(&bar[XB_XGEN(b.x)], 1u);
            asm volatile("s_waitcnt vmcnt(0)" ::: "memory");
        } else {
            XB_SPIN(xb_ld(&bar[XB_XGEN(b.x)]) == gen, bar);
            __builtin_amdgcn_fence(__ATOMIC_ACQUIRE, "agent");
            asm volatile("s_waitcnt vmcnt(0)" ::: "memory");
        }
    }
    __syncthreads();
}

struct Frame {
    LAS unsigned char* lds;
    volatile LAS unsigned* MISC;
    unsigned* ctl;
    int tid, lane, wave, vcu, G;
    const float *x, *c, *ctx, *c_ctx, *w_mod, *b_mod, *g_pre_mix, *g_post_mix, *g_pre_ffn, *g_post_ffn, *w_in, *a_sink, *b_rpb,
                *w_branch_a, *w_branch_b, *w_out, *w_router, *b_router, *w_gate_up, *b_gate_up, *w_down, *b_down;
    float* out;
    float *modx, *modc, *rope;
    bf16 *win_t, *wa_t, *wb_t, *wout_t, *wgu_t, *wd_t, *xn, *p, *yab, *merged, *mix, *act, *y;
    int *tope, *topp, *tok; float* topw;
};

template <int MODE> __device__ __forceinline__ int dst_row(int n) {
    if (MODE == 0) return n;
    const int up = n >> 10, j = n & 1023; return ((j >> 4) << 5) + (up << 4) + (j & 15);
}
template <int MODE> __device__ __forceinline__ void p0_transpose_item(const float* W, int K, int N, bf16* WT, LAS float* scr, int item, int lane) {
    const int nblk = N / 32, kb = item / nblk, nb = item % nblk, k0 = 64 * kb, n0 = 32 * nb;
#pragma unroll 8
    for (int i = 0; i < 32; ++i) { const int kk = 2 * i + (lane >> 5); scr[kk * 33 + (lane & 31)] = W[(size_t)(k0 + kk) * N + n0 + (lane & 31)]; }
    asm volatile("s_waitcnt lgkmcnt(0)" ::: "memory");
    const int c = lane & 7;
#pragma unroll
    for (int j = 0; j < 4; ++j) { const int n = (lane >> 3) + 8 * j; const LAS float* s = scr + (8 * c) * 33 + n;
        u32x4 o; o.x = pk2(s[0 * 33], s[1 * 33]); o.y = pk2(s[2 * 33], s[3 * 33]); o.z = pk2(s[4 * 33], s[5 * 33]); o.w = pk2(s[6 * 33], s[7 * 33]);
        *(u32x4*)(WT + (size_t)dst_row<MODE>(n0 + n) * K + k0 + 8 * c) = o; }
    asm volatile("s_waitcnt lgkmcnt(0)" ::: "memory");
}
__device__ __forceinline__ void p0_mod_item(Frame& F, int item) {
    LAS float* sil = (LAS float*)F.lds;
    LAS float* red = (LAS float*)(F.lds + 40960);
    for (int i = F.tid; i < 9 * 1024; i += NTHREADS) { const int r = i >> 10, k = i & 1023; const float cv = r < 8 ? F.c[r * 1024 + k] : F.c_ctx[k]; sil[i] = cv / (1.f + expf(-cv)); }
    __syncthreads();
    const int n0 = item * 32, cq = F.tid & 7, kl = F.tid >> 3;
    float acc[9][4];
#pragma unroll
    for (int r = 0; r < 9; ++r)
#pragma unroll
        for (int j = 0; j < 4; ++j) acc[r][j] = 0.f;
    for (int k = kl; k < 1024; k += 64) {
        const f32x4 w = *(const f32x4*)(F.w_mod + (size_t)k * 6144 + n0 + 4 * cq);
#pragma unroll
        for (int r = 0; r < 9; ++r) { const float s = sil[r * 1024 + k]; acc[r][0] += s * w.x; acc[r][1] += s * w.y; acc[r][2] += s * w.z; acc[r][3] += s * w.w; }
    }
#pragma unroll
    for (int r = 0; r < 9; ++r)
#pragma unroll
        for (int j = 0; j < 4; ++j) { float v = acc[r][j]; v += __shfl_xor(v, 8); v += __shfl_xor(v, 16); v += __shfl_xor(v, 32); if (F.lane < 8) red[(F.wave * 8 + cq) * 36 + r * 4 + j] = v; }
    __syncthreads();
    if (F.tid < 288) { const int q = F.tid / 36, rj = F.tid % 36, r = rj >> 2, j = rj & 3; float s = 0.f;
#pragma unroll
        for (int w = 0; w < 8; ++w) s += red[(w * 8 + q) * 36 + rj];
        const int n = n0 + 4 * q + j; s += F.b_mod[n];
        if (r < 8) F.modx[r * 6144 + n] = s; else F.modc[n] = s; }
    __syncthreads();
}
__device__ __forceinline__ void p0_prologue(Frame& F) {
    if (F.vcu < 192) p0_mod_item(F, F.vcu);
    if (F.vcu == 255 || (F.G < 256 && F.vcu == F.G - 1)) {
        for (int i = F.tid; i < 1024; i += NTHREADS) { const int pos = i >> 4, f = i & 15; const float inv = powf(10000.f, -(float)f / 16.f); const float ang = (float)pos * inv;
            F.rope[2 * i] = cosf(ang); F.rope[2 * i + 1] = sinf(ang); }
    }
    LAS float* scr = (LAS float*)(F.lds + F.wave * 16384);
    const int gw = F.vcu * NWAVES + F.wave, NGW = F.G * NWAVES;
    constexpr int I_IN = 16 * 136, I_A = 8 * 32, I_OUT = 16 * 32, I_GU = 16 * 64, I_D = 16 * 32;
    constexpr int NITEMS = I_IN + 2 * I_A + I_OUT + NE * I_GU + NE * I_D;
    for (int it = gw; it < NITEMS; it += NGW) {
        int r = it;
        if (r < I_IN) { p0_transpose_item<0>(F.w_in, 1024, INC, F.win_t, scr, r, F.lane); continue; } r -= I_IN;
        if (r < I_A) { p0_transpose_item<0>(F.w_branch_a, 512, 1024, F.wa_t, scr, r, F.lane); continue; } r -= I_A;
        if (r < I_A) { p0_transpose_item<0>(F.w_branch_b, 512, 1024, F.wb_t, scr, r, F.lane); continue; } r -= I_A;
        if (r < I_OUT) { p0_transpose_item<0>(F.w_out, 1024, 1024, F.wout_t, scr, r, F.lane); continue; } r -= I_OUT;
        if (r < NE * I_GU) { const int e = r / I_GU; p0_transpose_item<1>(F.w_gate_up + (size_t)e * 1024 * 2048, 1024, 2048, F.wgu_t + (size_t)e * 2048 * 1024, scr, r % I_GU, F.lane); continue; } r -= NE * I_GU;
        { const int e = r / I_D; p0_transpose_item<0>(F.w_down + (size_t)e * 1024 * 1024, 1024, 1024, F.wd_t + (size_t)e * 1024 * 1024, scr, r % I_D, F.lane); }
    }
}

__device__ __forceinline__ void p1_prenorm(Frame& F) {
    const int gw = F.vcu * NWAVES + F.wave, NGW = F.G * NWAVES;
    for (int m = gw; m < MA; m += NGW) {
        const float* xrow = m < MT ? F.x + (size_t)m * DM : F.ctx + (size_t)(m - MT) * DM;
        const float* sh = m < MT ? F.modx + (m / SEQ) * 6144 : F.modc;
        const float* sc = sh + 1024;
        f32x4 v[4]; float s = 0.f;
#pragma unroll
        for (int j = 0; j < 4; ++j) { v[j] = ((const f32x4*)xrow)[F.lane + 64 * j]; s += (v[j].x * v[j].x + v[j].y * v[j].y) + (v[j].z * v[j].z + v[j].w * v[j].w); }
        const float rs = 1.f / sqrtf(wave_sum(s) * (1.f / DM) + NORM_EPS);
        unsigned long long* o8 = (unsigned long long*)(F.xn + (size_t)m * DM) + F.lane;
#pragma unroll
        for (int j = 0; j < 4; ++j) { const int q = F.lane + 64 * j; const f32x4 g = ((const f32x4*)F.g_pre_mix)[q], a = ((const f32x4*)sh)[q], b = ((const f32x4*)sc)[q];
            const float h0 = v[j].x * rs * g.x * (1.f + b.x) + a.x, h1 = v[j].y * rs * g.y * (1.f + b.y) + a.y, h2 = v[j].z * rs * g.z * (1.f + b.z) + a.z, h3 = v[j].w * rs * g.w * (1.f + b.w) + a.w;
            o8[64 * j] = (unsigned long long)pk2(h0, h1) | ((unsigned long long)pk2(h2, h3) << 32); }
    }
}

__device__ __forceinline__ void wave_gemm_32x32(f32x4 (&acc)[2][2], const bf16* a0, const bf16* a1, const bf16* b0, const bf16* b1, int K, int fq) {
#pragma unroll 4
    for (int k = 0; k < K; k += 32) {
        const bf16x8 A0 = *(const bf16x8*)(a0 + k + 8 * fq), A1 = *(const bf16x8*)(a1 + k + 8 * fq);
        const bf16x8 B0 = *(const bf16x8*)(b0 + k + 8 * fq), B1 = *(const bf16x8*)(b1 + k + 8 * fq);
        acc[0][0] = __builtin_amdgcn_mfma_f32_16x16x32_bf16(B0, A0, acc[0][0], 0, 0, 0);
        acc[0][1] = __builtin_amdgcn_mfma_f32_16x16x32_bf16(B1, A0, acc[0][1], 0, 0, 0);
        acc[1][0] = __builtin_amdgcn_mfma_f32_16x16x32_bf16(B0, A1, acc[1][0], 0, 0, 0);
        acc[1][1] = __builtin_amdgcn_mfma_f32_16x16x32_bf16(B1, A1, acc[1][1], 0, 0, 0);
    }
}
__device__ __forceinline__ void zero_acc(f32x4 (&acc)[2][2]) {
#pragma unroll
    for (int i = 0; i < 2; ++i)
#pragma unroll
        for (int j = 0; j < 2; ++j) acc[i][j] = (f32x4){0.f, 0.f, 0.f, 0.f};
}
__device__ __forceinline__ void st4bf(bf16* p, float a, float b, float c, float d) { u32x2 w; w.x = pk2(a, b); w.y = pk2(c, d); *(u32x2*)p = w; }

__device__ __forceinline__ void p2_epilogue_tile(Frame& F, const f32x4 (&acc)[2][2], int r0, int c0, int fr, int fq) {
#pragma unroll
    for (int i = 0; i < 2; ++i) {
        const int row = r0 + 16 * i + fr; const bool is_ctx = row >= MT; const int t = row & (SEQ - 1);
        f32x4 v0 = acc[i][0], v1 = acc[i][1];
        if (c0 < C_VA) {
            if (!is_ctx) { const int axis = (c0 >> 5) & 1, pos = axis ? (t & 63) : (t >> 6); const float* rp = F.rope + (pos * 16 + 4 * fq) * 2;
#pragma unroll
                for (int e = 0; e < 4; ++e) { const float cs = rp[2 * e], sn = rp[2 * e + 1], x1 = v0[e], x2 = v1[e]; v0[e] = x1 * cs - x2 * sn; v1[e] = x2 * cs + x1 * sn; } }
            if (c0 < C_KA) { v0 = v0 * 0.125f; v1 = v1 * 0.125f; }
        } else if (c0 < C_QB) {
        } else if (c0 < C_KB) { v0 = v0 * 0.125f; v1 = v1 * 0.125f;
        } else if (c0 < C_GA) {
        } else {
#pragma unroll
            for (int e = 0; e < 4; ++e) { v0[e] = sigmoidf_(v0[e]); v1[e] = sigmoidf_(v1[e]); }
        }
        bf16* o = F.p + (size_t)row * INC + c0 + 4 * fq;
        st4bf(o, v0[0], v0[1], v0[2], v0[3]); st4bf(o + 16, v1[0], v1[1], v1[2], v1[3]);
    }
}
__device__ __forceinline__ void p2_inproj_simple(Frame& F) {
    const int gw = F.vcu * NWAVES + F.wave, NGW = F.G * NWAVES, fr = F.lane & 15, fq = F.lane >> 4;
    constexpr int NCT = INC / 32, NRT_L = MT / 32, NCT_C = (256 + 1024) / 32;
    constexpr int NT = NRT_L * NCT + (MC / 32) * NCT_C;
    for (int tl = gw; tl < NT; tl += NGW) {
        int r0, c0;
        if (tl < NRT_L * NCT) { r0 = (tl / NCT) * 32; c0 = (tl % NCT) * 32; }
        else { const int u = tl - NRT_L * NCT; r0 = MT + (u / NCT_C) * 32; const int cc = u % NCT_C; c0 = cc < 8 ? C_KA + cc * 32 : C_KB + (cc - 8) * 32; }
        f32x4 acc[2][2]; zero_acc(acc);
        const bf16* a0 = F.xn + (size_t)(r0 + fr) * DM; const bf16* b0 = F.win_t + (size_t)(c0 + fr) * DM;
        wave_gemm_32x32(acc, a0, a0 + 16 * DM, b0, b0 + 16 * DM, DM, fq);
        p2_epilogue_tile(F, acc, r0, c0, fr, fq);
    }
}

__device__ __forceinline__ void attn_key(const float (&q)[64], const bf16* kp, const bf16* vp, float bias, float& m, float& l, float (&o)[64]) {
    float s = bias;
#pragma unroll
    for (int d8 = 0; d8 < 8; ++d8) { const u32x4 kk = *(const u32x4*)(kp + 8 * d8);
        s += q[8 * d8 + 0] * bf2f(kk.x & 0xffffu) + q[8 * d8 + 1] * bf2f(kk.x >> 16) + q[8 * d8 + 2] * bf2f(kk.y & 0xffffu) + q[8 * d8 + 3] * bf2f(kk.y >> 16)
           + q[8 * d8 + 4] * bf2f(kk.z & 0xffffu) + q[8 * d8 + 5] * bf2f(kk.z >> 16) + q[8 * d8 + 6] * bf2f(kk.w & 0xffffu) + q[8 * d8 + 7] * bf2f(kk.w >> 16); }
    const float mn = fmaxf(m, s), al = __expf(m - mn), pe = __expf(s - mn);
    l = l * al + pe; m = mn;
#pragma unroll
    for (int d8 = 0; d8 < 8; ++d8) { const u32x4 vv = *(const u32x4*)(vp + 8 * d8);
        o[8 * d8 + 0] = o[8 * d8 + 0] * al + pe * bf2f(vv.x & 0xffffu); o[8 * d8 + 1] = o[8 * d8 + 1] * al + pe * bf2f(vv.x >> 16);
        o[8 * d8 + 2] = o[8 * d8 + 2] * al + pe * bf2f(vv.y & 0xffffu); o[8 * d8 + 3] = o[8 * d8 + 3] * al + pe * bf2f(vv.y >> 16);
        o[8 * d8 + 4] = o[8 * d8 + 4] * al + pe * bf2f(vv.z & 0xffffu); o[8 * d8 + 5] = o[8 * d8 + 5] * al + pe * bf2f(vv.z >> 16);
        o[8 * d8 + 6] = o[8 * d8 + 6] * al + pe * bf2f(vv.w & 0xffffu); o[8 * d8 + 7] = o[8 * d8 + 7] * al + pe * bf2f(vv.w >> 16); }
}
__device__ __forceinline__ void p3_attn_naive(Frame& F) {
    const int gt = F.vcu * NTHREADS + F.tid, NGT = F.G * NTHREADS;
    for (int w = gt; w < 2 * 8 * MT; w += NGT) {
        const int br = w / (8 * MT), h = (w / MT) & 7, t = w % MT, b = t / SEQ, tl = t % SEQ;
        float q[64], o[64];
        const bf16* qp = F.p + (size_t)t * INC + (br ? C_QB : C_QA) + h * 64;
#pragma unroll
        for (int d = 0; d < 64; ++d) { q[d] = bf2f(qp[d]); o[d] = 0.f; }
        float m, l;
        if (br == 0) {
            const int kvh = h >> 2; m = F.a_sink[h]; l = 1.f;
            const int j0 = tl - 128 < 0 ? 0 : tl - 128, j1 = tl + 128 > SEQ - 1 ? SEQ - 1 : tl + 128;
            for (int j = j0; j <= j1; ++j) { const bf16* rp = F.p + (size_t)(b * SEQ + j) * INC; attn_key(q, rp + C_KA + kvh * 64, rp + C_VA + kvh * 64, 0.f, m, l, o); }
            for (int j = 0; j < CTXL; ++j) { const bf16* rp = F.p + (size_t)(MT + b * CTXL + j) * INC; attn_key(q, rp + C_KA + kvh * 64, rp + C_VA + kvh * 64, 0.f, m, l, o); }
        } else {
            m = -1e30f; l = 0.f;
            const int r = tl >> 6, c = tl & 63; int rs = r - 4; rs = rs < 0 ? 0 : (rs > 24 ? 24 : rs); int cs = c - 8; cs = cs < 0 ? 0 : (cs > 48 ? 48 : cs);
            for (int kr = rs; kr < rs + 8; ++kr)
                for (int kc = cs; kc < cs + 16; ++kc) { const bf16* rp = F.p + (size_t)(b * SEQ + kr * 64 + kc) * INC;
                    int dc = kc - c; dc = dc < -15 ? -15 : (dc > 15 ? 15 : dc);
                    const float bias = F.b_rpb[h * 15 * 31 + (kr - r + 7) * 31 + dc + 15];
                    attn_key(q, rp + C_KB + h * 64, rp + C_VB + h * 64, bias, m, l, o); }
            for (int j = 0; j < CTXL; ++j) { const bf16* rp = F.p + (size_t)(MT + b * CTXL + j) * INC; attn_key(q, rp + C_KB + h * 64, rp + C_VB + h * 64, 0.f, m, l, o); }
        }
        const float il = 1.f / l; bf16* op = F.yab + (size_t)t * DM + br * 512 + h * 64;
#pragma unroll
        for (int d = 0; d < 64; d += 4) st4bf(op + d, o[d] * il, o[d + 1] * il, o[d + 2] * il, o[d + 3] * il);
    }
}

__device__ __forceinline__ void p4_merge_simple(Frame& F) {
    const int gw = F.vcu * NWAVES + F.wave, NGW = F.G * NWAVES, fr = F.lane & 15, fq = F.lane >> 4;
    constexpr int NCT = DM / 32, NT = (MT / 32) * NCT;
    for (int tl = gw; tl < NT; tl += NGW) {
        const int r0 = (tl / NCT) * 32, c0 = (tl % NCT) * 32;
        f32x4 accA[2][2], accB[2][2]; zero_acc(accA); zero_acc(accB);
        const bf16* a0 = F.yab + (size_t)(r0 + fr) * DM;
        const bf16* ba = F.wa_t + (size_t)(c0 + fr) * 512; const bf16* bb = F.wb_t + (size_t)(c0 + fr) * 512;
        wave_gemm_32x32(accA, a0, a0 + 16 * DM, ba, ba + 16 * 512, 512, fq);
        wave_gemm_32x32(accB, a0 + 512, a0 + 512 + 16 * DM, bb, bb + 16 * 512, 512, fq);
#pragma unroll
        for (int i = 0; i < 2; ++i)
#pragma unroll
            for (int j = 0; j < 2; ++j) { const int row = r0 + 16 * i + fr, col = c0 + 16 * j + 4 * fq;
                const u32x2 ga = *(const u32x2*)(F.p + (size_t)row * INC + C_GA + col), gb = *(const u32x2*)(F.p + (size_t)row * INC + C_GB + col);
                const f32x4 a = accA[i][j], b = accB[i][j];
                st4bf(F.merged + (size_t)row * DM + col, bf2f(ga.x & 0xffffu) * a[0] + bf2f(gb.x & 0xffffu) * b[0], bf2f(ga.x >> 16) * a[1] + bf2f(gb.x >> 16) * b[1],
                      bf2f(ga.y & 0xffffu) * a[2] + bf2f(gb.y & 0xffffu) * b[2], bf2f(ga.y >> 16) * a[3] + bf2f(gb.y >> 16) * b[3]); }
    }
}
__device__ __forceinline__ void p5_outproj_simple(Frame& F) {
    const int gw = F.vcu * NWAVES + F.wave, NGW = F.G * NWAVES, fr = F.lane & 15, fq = F.lane >> 4;
    constexpr int NCT = DM / 32, NT = (MT / 32) * NCT;
    for (int tl = gw; tl < NT; tl += NGW) {
        const int r0 = (tl / NCT) * 32, c0 = (tl % NCT) * 32;
        f32x4 acc[2][2]; zero_acc(acc);
        const bf16* a0 = F.merged + (size_t)(r0 + fr) * DM; const bf16* b0 = F.wout_t + (size_t)(c0 + fr) * DM;
        wave_gemm_32x32(acc, a0, a0 + 16 * DM, b0, b0 + 16 * DM, DM, fq);
#pragma unroll
        for (int i = 0; i < 2; ++i)
#pragma unroll
            for (int j = 0; j < 2; ++j) { const f32x4 a = acc[i][j]; st4bf(F.mix + (size_t)(r0 + 16 * i + fr) * DM + c0 + 16 * j + 4 * fq, a[0], a[1], a[2], a[3]); }
    }
}

__device__ __forceinline__ void p6_row_router(Frame& F) {
    const int gw = F.vcu * NWAVES + F.wave, NGW = F.G * NWAVES;
    for (int m = gw; m < MT; m += NGW) {
        const float* md = F.modx + (m / SEQ) * 6144;
        f32x4 mx[4], xv[4]; float s = 0.f;
        const unsigned long long* mp = (const unsigned long long*)(F.mix + (size_t)m * DM) + F.lane;
#pragma unroll
        for (int j = 0; j < 4; ++j) { const unsigned long long w = mp[64 * j]; const unsigned lo = (unsigned)w, hi = (unsigned)(w >> 32);
            mx[j] = (f32x4){bf2f(lo & 0xffffu), bf2f(lo >> 16), bf2f(hi & 0xffffu), bf2f(hi >> 16)};
            s += (mx[j].x * mx[j].x + mx[j].y * mx[j].y) + (mx[j].z * mx[j].z + mx[j].w * mx[j].w); }
        const float r1 = 1.f / sqrtf(wave_sum(s) * (1.f / DM) + NORM_EPS);
        float s2 = 0.f;
#pragma unroll
        for (int j = 0; j < 4; ++j) { const int q = F.lane + 64 * j; const f32x4 x0 = ((const f32x4*)(F.x + (size_t)m * DM))[q], g = ((const f32x4*)F.g_post_mix)[q], g1 = ((const f32x4*)(md + 2048))[q];
            xv[j] = x0 + g1 * (mx[j] * r1 * g); ((f32x4*)(F.out + (size_t)m * DM))[q] = xv[j];
            s2 += (xv[j].x * xv[j].x + xv[j].y * xv[j].y) + (xv[j].z * xv[j].z + xv[j].w * xv[j].w); }
        const float r2 = 1.f / sqrtf(wave_sum(s2) * (1.f / DM) + NORM_EPS);
        unsigned long long* o8 = (unsigned long long*)(F.xn + (size_t)m * DM) + F.lane;
        float lg[32];
#pragma unroll
        for (int e = 0; e < 32; ++e) lg[e] = 0.f;
#pragma unroll
        for (int j = 0; j < 4; ++j) { const int q = F.lane + 64 * j; const f32x4 g = ((const f32x4*)F.g_pre_ffn)[q], sh = ((const f32x4*)(md + 3072))[q], sc = ((const f32x4*)(md + 4096))[q];
            const f32x4 h = xv[j] * r2 * g * (sc + 1.f) + sh;
            o8[64 * j] = (unsigned long long)pk2(h.x, h.y) | ((unsigned long long)pk2(h.z, h.w) << 32);
#pragma unroll
            for (int kk = 0; kk < 4; ++kk) { const float hv = h[kk]; const f32x4* wr = (const f32x4*)(F.w_router + (size_t)(4 * q + kk) * NE);
#pragma unroll
                for (int e4 = 0; e4 < 8; ++e4) { const f32x4 w = wr[e4]; lg[4 * e4] += hv * w.x; lg[4 * e4 + 1] += hv * w.y; lg[4 * e4 + 2] += hv * w.z; lg[4 * e4 + 3] += hv * w.w; } } }
#pragma unroll
        for (int e = 0; e < 32; ++e) lg[e] = wave_sum(lg[e]) + F.b_router[e];
        int ei[4]; float ev[4];
#pragma unroll
        for (int k = 0; k < 4; ++k) { float best = -INFINITY; int bi = 0;
#pragma unroll
            for (int e = 0; e < 32; ++e) if (lg[e] > best) { best = lg[e]; bi = e; }
#pragma unroll
            for (int e = 0; e < 32; ++e) if (e == bi) lg[e] = -INFINITY;
            ei[k] = bi; ev[k] = best; }
        const float w0 = 1.f, w1 = expf(ev[1] - ev[0]), w2 = expf(ev[2] - ev[0]), w3 = expf(ev[3] - ev[0]), inv = 1.f / (w0 + w1 + w2 + w3);
        if (F.lane < 4) { const int k = F.lane; const int e = k == 0 ? ei[0] : (k == 1 ? ei[1] : (k == 2 ? ei[2] : ei[3])); const float wv = (k == 0 ? w0 : (k == 1 ? w1 : (k == 2 ? w2 : w3))) * inv;
            const int pos = (int)__hip_atomic_fetch_add(F.ctl + CW_CNT + 64 * e, 1u, RLX_AGENT);
            F.tok[e * MT + pos] = m; F.tope[m * 4 + k] = e; F.topp[m * 4 + k] = pos; F.topw[m * 4 + k] = wv; }
    }
}

__device__ __forceinline__ void moe_tables(Frame& F, int RT) {
    LAS int* T = (LAS int*)F.lds;
    if (F.tid == 0) { int pt = 0, pb = 0;
        for (int e = 0; e < NE; ++e) { const int n = (int)__hip_atomic_load(F.ctl + CW_CNT + 64 * e, RLX_AGENT); T[e] = n; T[32 + e] = pt; T[96 + e] = pb; pt += (n + RT - 1) / RT; pb += ((n + 255) / 256) * 256; }
        T[32 + NE] = pt; T[96 + NE] = pb; }
    __syncthreads();
}
__device__ __forceinline__ void p7_gateup_simple(Frame& F) {
    moe_tables(F, 32);
    const LAS int* T = (const LAS int*)F.lds;
    const int gw = F.vcu * NWAVES + F.wave, NGW = F.G * NWAVES, fr = F.lane & 15, fq = F.lane >> 4;
    const int NT = T[32 + NE] * 64;
    for (int tl = gw; tl < NT; tl += NGW) {
        const int rt = tl >> 6, ct = tl & 63; int e = 0;
        while (e < NE - 1 && T[32 + e + 1] <= rt) ++e;
        const int n = T[e], p0 = (rt - T[32 + e]) * 32, base = T[96 + e];
        const int pa = p0 + fr, pb = p0 + 16 + fr;
        const int ta = F.tok[e * MT + (pa < n ? pa : 0)], tb = F.tok[e * MT + (pb < n ? pb : 0)];
        f32x4 acc[2][2]; zero_acc(acc);
        const bf16* b0 = F.wgu_t + ((size_t)e * 2048 + ct * 32 + fr) * DM;
        wave_gemm_32x32(acc, F.xn + (size_t)ta * DM, F.xn + (size_t)tb * DM, b0, b0 + 16 * DM, DM, fq);
        const int jg = ct * 16 + 4 * fq; const f32x4 bg = *(const f32x4*)(F.b_gate_up + (size_t)e * 2048 + jg), bu = *(const f32x4*)(F.b_gate_up + (size_t)e * 2048 + 1024 + jg);
#pragma unroll
        for (int i = 0; i < 2; ++i) { float r[4];
#pragma unroll
            for (int q = 0; q < 4; ++q) { float g = acc[i][0][q] + bg[q], u = acc[i][1][q] + bu[q]; g = fminf(g, 7.f); u = fminf(fmaxf(u, -7.f), 7.f); r[q] = (u + 1.f) * (g * sigmoidf_(1.702f * g)); }
            st4bf(F.act + (size_t)(base + p0 + 16 * i + fr) * DE + jg, r[0], r[1], r[2], r[3]); }
    }
}
__device__ __forceinline__ void p8_down_simple(Frame& F) {
    moe_tables(F, 32);
    const LAS int* T = (const LAS int*)F.lds;
    const int gw = F.vcu * NWAVES + F.wave, NGW = F.G * NWAVES, fr = F.lane & 15, fq = F.lane >> 4;
    const int NT = T[32 + NE] * 32;
    for (int tl = gw; tl < NT; tl += NGW) {
        const int rt = tl >> 5, ct = tl & 31; int e = 0;
        while (e < NE - 1 && T[32 + e + 1] <= rt) ++e;
        const int p0 = (rt - T[32 + e]) * 32, base = T[96 + e];
        f32x4 acc[2][2]; zero_acc(acc);
        const bf16* a0 = F.act + (size_t)(base + p0 + fr) * DE; const bf16* b0 = F.wd_t + ((size_t)e * 1024 + ct * 32 + fr) * DE;
        wave_gemm_32x32(acc, a0, a0 + 16 * DE, b0, b0 + 16 * DE, DE, fq);
#pragma unroll
        for (int i = 0; i < 2; ++i)
#pragma unroll
            for (int j = 0; j < 2; ++j) { const int col = ct * 32 + 16 * j + 4 * fq; const f32x4 bd = *(const f32x4*)(F.b_down + (size_t)e * 1024 + col); const f32x4 a = acc[i][j] + bd;
                st4bf(F.y + (size_t)(base + p0 + 16 * i + fr) * DM + col, a[0], a[1], a[2], a[3]); }
    }
}
__device__ __forceinline__ void p9_final(Frame& F) {
    moe_tables(F, 32);
    const LAS int* T = (const LAS int*)F.lds;
    const int gw = F.vcu * NWAVES + F.wave, NGW = F.G * NWAVES;
    for (int m = gw; m < MT; m += NGW) {
        const float* md = F.modx + (m / SEQ) * 6144;
        f32x4 f[4];
#pragma unroll
        for (int j = 0; j < 4; ++j) f[j] = (f32x4){0.f, 0.f, 0.f, 0.f};
#pragma unroll
        for (int k = 0; k < 4; ++k) { const int e = F.tope[m * 4 + k], pos = F.topp[m * 4 + k]; const float wv = F.topw[m * 4 + k];
            const unsigned long long* yp = (const unsigned long long*)(F.y + (size_t)(T[96 + e] + pos) * DM) + F.lane;
#pragma unroll
            for (int j = 0; j < 4; ++j) { const unsigned long long w = yp[64 * j]; const unsigned lo = (unsigned)w, hi = (unsigned)(w >> 32);
                f[j] += (f32x4){bf2f(lo & 0xffffu), bf2f(lo >> 16), bf2f(hi & 0xffffu), bf2f(hi >> 16)} * wv; } }
        float s = 0.f;
#pragma unroll
        for (int j = 0; j < 4; ++j) s += (f[j].x * f[j].x + f[j].y * f[j].y) + (f[j].z * f[j].z + f[j].w * f[j].w);
        const float rs = 1.f / sqrtf(wave_sum(s) * (1.f / DM) + NORM_EPS);
#pragma unroll
        for (int j = 0; j < 4; ++j) { const int q = F.lane + 64 * j; const f32x4 g = ((const f32x4*)F.g_post_ffn)[q], g2 = ((const f32x4*)(md + 5120))[q];
            f32x4* op = (f32x4*)(F.out + (size_t)m * DM) + q; *op = *op + g2 * (f[j] * rs * g); }
    }
}

struct Args { const float* in[22]; float* out; unsigned char* ws; int ph_lo, ph_hi; };
__global__ void __launch_bounds__(NTHREADS, 2) fwd_kernel(Args args) {
    extern __shared__ __attribute__((aligned(16))) unsigned char lds[];
    Frame F;
    F.lds = (LAS unsigned char*)lds; F.MISC = (volatile LAS unsigned*)(F.lds + MISC_OFF);
    F.tid = threadIdx.x; F.lane = F.tid & 63; F.wave = __builtin_amdgcn_readfirstlane(F.tid >> 6);
    F.G = gridDim.x; { const int bx = blockIdx.x; F.vcu = (F.G % 8 == 0) ? (bx % 8) * (F.G / 8) + bx / 8 : bx; }
    unsigned char* ws = args.ws;
    F.ctl = (unsigned*)(ws + WS_CTL);
    F.x = args.in[0]; F.c = args.in[1]; F.ctx = args.in[2]; F.c_ctx = args.in[3]; F.w_mod = args.in[4]; F.b_mod = args.in[5];
    F.g_pre_mix = args.in[6]; F.g_post_mix = args.in[7]; F.g_pre_ffn = args.in[8]; F.g_post_ffn = args.in[9]; F.w_in = args.in[10];
    F.a_sink = args.in[11]; F.b_rpb = args.in[12]; F.w_branch_a = args.in[13]; F.w_branch_b = args.in[14]; F.w_out = args.in[15];
    F.w_router = args.in[16]; F.b_router = args.in[17]; F.w_gate_up = args.in[18]; F.b_gate_up = args.in[19]; F.w_down = args.in[20]; F.b_down = args.in[21];
    F.out = args.out;
    F.modx = (float*)(ws + WS_MODX); F.modc = (float*)(ws + WS_MODC); F.rope = (float*)(ws + WS_ROPE);
    F.win_t = (bf16*)(ws + WS_WIN); F.wa_t = (bf16*)(ws + WS_WA); F.wb_t = (bf16*)(ws + WS_WB); F.wout_t = (bf16*)(ws + WS_WOUT);
    F.wgu_t = (bf16*)(ws + WS_WGU); F.wd_t = (bf16*)(ws + WS_WD); F.xn = (bf16*)(ws + WS_XN); F.p = (bf16*)(ws + WS_P);
    F.yab = (bf16*)(ws + WS_YAB); F.merged = (bf16*)(ws + WS_MERGED); F.mix = (bf16*)(ws + WS_MIX); F.act = (bf16*)(ws + WS_ACT); F.y = (bf16*)(ws + WS_Y);
    F.tope = (int*)(ws + WS_TOPE); F.topp = (int*)(ws + WS_TOPP); F.topw = (float*)(ws + WS_TOPW); F.tok = (int*)(ws + WS_TOK);
    for (int u = F.tid; u < (LDS_BYTES - 131072) / 4; u += NTHREADS) ((LAS unsigned*)(F.lds + 131072))[u] = 0u;
    __syncthreads();
    XcdBarrier bar; bar.bar = F.ctl + CW_BAR; bar.x = 0; bar.st = nullptr;
    if (MK_N_LAUNCHES != PER_PHASE) bar = xcd_barrier_post(F.ctl + CW_BAR, F.MISC + 8);
    const int lo = args.ph_lo, hi = args.ph_hi;
#define IN(k) (lo <= (k) && (k) < hi)
#define SEAM(k) do { if (IN(k) && IN((k) + 1)) xcd_barrier(bar); } while (0)
    if (IN(0)) { p0_prologue(F); } SEAM(0);
    if (IN(1)) { p1_prenorm(F); } SEAM(1);
    if (IN(2)) { p2_inproj_simple(F); } SEAM(2);
    if (IN(3)) { p3_attn_naive(F); } SEAM(3);
    if (IN(4)) { p4_merge_simple(F); } SEAM(4);
    if (IN(5)) { p5_outproj_simple(F); } SEAM(5);
    if (IN(6)) { p6_row_router(F); } SEAM(6);
    if (IN(7)) { p7_gateup_simple(F); } SEAM(7);
    if (IN(8)) { p8_down_simple(F); } SEAM(8);
    if (IN(9)) { p9_final(F); }
#undef IN
#undef SEAM
}

extern "C" void kernel_launch(void* const* d_in, const int* in_sizes, int n_in, void* d_out, int out_size, void* d_ws, size_t ws_size, hipStream_t stream) {
    static int grid = 0;
    if (grid == 0) {
        if (n_in != 22 || out_size != MT * DM || ws_size < WS_END) { fprintf(stderr, "kernel_launch: unexpected problem (n_in %d, out %d, ws %zu); nothing launched\n", n_in, out_size, ws_size); grid = -1; return; }
        int dev = 0, cus = 0, per_cu = 0;
        if (hipGetDevice(&dev) != hipSuccess || hipDeviceGetAttribute(&cus, hipDeviceAttributeMultiprocessorCount, dev) != hipSuccess) { grid = -1; return; }
        if (hipFuncSetAttribute((const void*)fwd_kernel, hipFuncAttributeMaxDynamicSharedMemorySize, LDS_BYTES) != hipSuccess) { fprintf(stderr, "kernel_launch: hipFuncSetAttribute failed\n"); grid = -1; return; }
        if (hipOccupancyMaxActiveBlocksPerMultiprocessor(&per_cu, (const void*)fwd_kernel, NTHREADS, LDS_BYTES) != hipSuccess || per_cu < 1) { fprintf(stderr, "kernel_launch: occupancy query says %d blocks per CU\n", per_cu); grid = -1; (void)hipGetLastError(); return; }
        grid = cus;
    }
    if (grid < 0) return;
    if (hipMemsetAsync((char*)d_ws + WS_CTL, 0, CTL_ZERO_BYTES, stream) != hipSuccess) return;
    Args a{};
    for (int i = 0; i < 22; ++i) a.in[i] = (const float*)d_in[i];
    a.out = (float*)d_out; a.ws = (unsigned char*)d_ws;
    if (MK_N_LAUNCHES == 1) { a.ph_lo = 0; a.ph_hi = PER_PHASE; hipLaunchKernelGGL(fwd_kernel, dim3(grid), dim3(NTHREADS), LDS_BYTES, stream, a); }
    else for (int li = 0; li < PER_PHASE; ++li) { a.ph_lo = li; a.ph_hi = li + 1; hipLaunchKernelGGL(fwd_kernel, dim3(grid), dim3(NTHREADS), LDS_BYTES, stream, a); }
}
```

```cpp
#include <hip/hip_runtime.h>
#include <cstdio>
#include <cstdint>

#ifndef MK_N_LAUNCHES
#define MK_N_LAUNCHES 1
#endif

#ifndef FAST_GEMM
#define FAST_GEMM 1
#endif
#define GAS __attribute__((address_space(1)))
#define LAS __attribute__((address_space(3)))
typedef unsigned short bf16;
typedef short bf16x8 __attribute__((ext_vector_type(8)));
typedef float f32x4 __attribute__((ext_vector_type(4)));
typedef unsigned u32x4 __attribute__((ext_vector_type(4)));
typedef unsigned u32x2 __attribute__((ext_vector_type(2)));
typedef GAS unsigned gu32;

constexpr int DM = 1024, NB = 8, SEQ = 2048, CTXL = 256, HD = 64;
constexpr int MT = NB * SEQ;
constexpr int MC = NB * CTXL;
constexpr int MA = MT + MC;
constexpr int INC = 4352;
constexpr int C_QA = 0, C_KA = 512, C_VA = 640, C_QB = 768, C_KB = 1280, C_VB = 1792, C_GA = 2304, C_GB = 3328;
constexpr int NE = 32, TOPK = 4, DE = 1024;
constexpr int SLOTS = MT * TOPK + NE * 256;
constexpr float NORM_EPS = 1e-6f;
constexpr int NWAVES = 8, NTHREADS = 512;
constexpr int PER_PHASE = 10;

constexpr size_t MiB = 1u << 20;
constexpr size_t WS_CTL = 0, CTL_ZERO_BYTES = 1 * MiB;
constexpr size_t WS_MODX = 1 * MiB;
constexpr size_t WS_MODC = WS_MODX + 8 * 6144 * 4;
constexpr size_t WS_ROPE = WS_MODC + 6144 * 4;
constexpr size_t WS_WIN = 2 * MiB;
constexpr size_t WS_WA = 11 * MiB;
constexpr size_t WS_WB = 12 * MiB;
constexpr size_t WS_WOUT = 13 * MiB;
constexpr size_t WS_TOPE = 15 * MiB;
constexpr size_t WS_TOPP = WS_TOPE + 256 * 1024;
constexpr size_t WS_TOPW = WS_TOPP + 256 * 1024;
constexpr size_t WS_WGU = 16 * MiB;
constexpr size_t WS_WD = 144 * MiB;
constexpr size_t WS_XN = 208 * MiB;
constexpr size_t WS_P = 244 * MiB;
constexpr size_t WS_ACT = WS_P;
constexpr size_t WS_YAB = 397 * MiB;
constexpr size_t WS_MERGED = 429 * MiB;
constexpr size_t WS_MIX = 461 * MiB;
constexpr size_t WS_TOK = 493 * MiB;
constexpr size_t WS_Y = 496 * MiB;
constexpr size_t WS_END = 640 * MiB;
static_assert(WS_ACT + (size_t)SLOTS * 1024 * 2 <= WS_YAB + 0 * MiB + 32 * MiB, "ACT overlays P (and may run into YAB, dead by then)");
static_assert(WS_Y + (size_t)SLOTS * 1024 * 2 <= WS_END, "ws map");
constexpr int CW_BAR = 4096;
constexpr int CW_CNT = 16384;

constexpr int LDS_BYTES = 147456;
constexpr int MISC_OFF = 131072 + 320;
constexpr int TBL_OFF = 131072 + 1024;
constexpr int TOKC_OFF = 131072 + 2048;

#define RLX_AGENT __ATOMIC_RELAXED, __HIP_MEMORY_SCOPE_AGENT
__device__ __forceinline__ unsigned f2bf(float f) { unsigned u = __builtin_bit_cast(unsigned, f); return (u + 0x7fffu + ((u >> 16) & 1u)) >> 16; }
__device__ __forceinline__ unsigned pk2(float lo, float hi) { return f2bf(lo) | (f2bf(hi) << 16); }
__device__ __forceinline__ float bf2f(unsigned b) { return __builtin_bit_cast(float, b << 16); }
__device__ __forceinline__ float wave_sum(float v) {
#pragma unroll
    for (int o = 1; o < 64; o <<= 1) v += __shfl_xor(v, o);
    return v;
}
__device__ __forceinline__ float sigmoidf_(float x) { return 1.f / (1.f + __expf(-x)); }

#define XB_TMO      128
#define XB_XCNT(j)  (256  + 64 * (j))
#define XB_XSUB(j)  (1280 + 64 * (j))
#define XB_XGEN(j)  (2304 + 64 * (j))
#define XB_TOP      3328
#define XB_TOPGEN   3392
#define XCD_BAR_WORDS 3456
#define XB_SPIN_CAP (1u << 18)
__device__ __forceinline__ unsigned xb_ld(unsigned* p)              { return __hip_atomic_load(p, __ATOMIC_RELAXED, __HIP_MEMORY_SCOPE_AGENT); }
__device__ __forceinline__ unsigned xb_add(unsigned* p, unsigned v) { return __hip_atomic_fetch_add(p, v, __ATOMIC_RELAXED, __HIP_MEMORY_SCOPE_AGENT); }
__device__ __forceinline__ unsigned xb_xcc_id() { return (unsigned)__builtin_amdgcn_s_getreg((3 << 11) | 20) & 0xFu; }
#define XB_SPIN(cond, bar) do { unsigned _sp = 0; while (cond) { __builtin_amdgcn_s_sleep(1); \
    if ((++_sp & 255u) == 0u) { if (xb_ld(&(bar)[XB_TMO])) break; if (_sp > XB_SPIN_CAP) { atomicAdd(&(bar)[XB_TMO], 1u); break; } } } } while (0)
struct XcdBarrier { unsigned* bar; unsigned x; volatile LAS unsigned* st; };
__device__ __forceinline__ XcdBarrier xcd_barrier_post(unsigned* bar, volatile LAS unsigned* st) {
    XcdBarrier b; b.bar = bar; b.x = xb_xcc_id(); b.st = st;
    if (threadIdx.x == 0) (void)xb_add(&bar[XB_XCNT(b.x)], 1u);
    return b;
}
__device__ __forceinline__ void xcd_barrier_complete(unsigned* bar, unsigned x, unsigned& nloc, unsigned& nx) {
    const unsigned G = gridDim.x * gridDim.y * gridDim.z;
    unsigned sum, cnt, mine, sp = 0u;
    for (;;) {
        sum = 0u; cnt = 0u; mine = 0u;
#pragma unroll
        for (unsigned j = 0; j < 16; ++j) { const unsigned c = xb_ld(&bar[XB_XCNT(j)]); sum += c; cnt += (c > 0u) ? 1u : 0u; mine = (j == x) ? c : mine; }
        if (sum == G) break;
        __builtin_amdgcn_s_sleep(1);
        if ((++sp & 255u) == 0u) { if (xb_ld(&bar[XB_TMO])) break; if (sp > XB_SPIN_CAP) { atomicAdd(&bar[XB_TMO], 1u); break; } }
    }
    nloc = mine > 0u ? mine : 1u; nx = cnt > 0u ? cnt : 1u;
}
__device__ __forceinline__ void xcd_barrier(const XcdBarrier& b) {
    asm volatile("s_waitcnt vmcnt(0)" ::: "memory");
    __syncthreads();
    if (threadIdx.x == 0) {
        unsigned* bar = b.bar;
        __builtin_amdgcn_s_waitcnt(0);
        unsigned nloc = b.st[0], nx = b.st[1];
        if (nloc == 0u) { xcd_barrier_complete(bar, b.x, nloc, nx); b.st[0] = nloc; b.st[1] = nx; }
        const unsigned old = xb_add(&bar[XB_XSUB(b.x)], 1u);
        const unsigned gen = old / nloc;
        if (old + 1u == (gen + 1u) * nloc) {
            __builtin_amdgcn_fence(__ATOMIC_RELEASE, "agent");
            asm volatile("s_waitcnt vmcnt(0)" ::: "memory");
            const unsigned og = xb_add(&bar[XB_TOP], 1u);
            const unsigned tg = og / nx;
            if (og + 1u == (tg + 1u) * nx) xb_add(&bar[XB_TOPGEN], 1u);
            else XB_SPIN(xb_ld(&bar[XB_TOPGEN]) == tg, bar);
            __builtin_amdgcn_fence(__ATOMIC_ACQUIRE, "agent");
            xb_add(&bar[XB_XGEN(b.x)], 1u);
            asm volatile("s_waitcnt vmcnt(0)" ::: "memory");
        } else {
            XB_SPIN(xb_ld(&bar[XB_XGEN(b.x)]) == gen, bar);
            __builtin_amdgcn_fence(__ATOMIC_ACQUIRE, "agent");
            asm volatile("s_waitcnt vmcnt(0)" ::: "memory");
        }
    }
    __syncthreads();
}

struct Frame {
    LAS unsigned char* lds;
    volatile LAS unsigned* MISC;
    unsigned* ctl;
    int tid, lane, wave, vcu, G;
    const float *x, *c, *ctx, *c_ctx, *w_mod, *b_mod, *g_pre_mix, *g_post_mix, *g_pre_ffn, *g_post_ffn, *w_in, *a_sink, *b_rpb,
                *w_branch_a, *w_branch_b, *w_out, *w_router, *b_router, *w_gate_up, *b_gate_up, *w_down, *b_down;
    float* out;
    float *modx, *modc, *rope;
    bf16 *win_t, *wa_t, *wb_t, *wout_t, *wgu_t, *wd_t, *xn, *p, *yab, *merged, *mix, *act, *y;
    int *tope, *topp, *tok; float* topw;
};

template <int MODE> __device__ __forceinline__ int dst_row(int n) {
    if (MODE == 0) return n;
    const int up = n >> 10, j = n & 1023; return ((j >> 4) << 5) + (up << 4) + (j & 15);
}
template <int MODE> __device__ __forceinline__ void p0_transpose_item(const float* W, int K, int N, bf16* WT, LAS float* scr, int item, int lane) {
    const int nblk = N / 32, kb = item / nblk, nb = item % nblk, k0 = 64 * kb, n0 = 32 * nb;
#pragma unroll 8
    for (int i = 0; i < 32; ++i) { const int kk = 2 * i + (lane >> 5); scr[kk * 33 + (lane & 31)] = W[(size_t)(k0 + kk) * N + n0 + (lane & 31)]; }
    asm volatile("s_waitcnt lgkmcnt(0)" ::: "memory");
    const int c = lane & 7;
#pragma unroll
    for (int j = 0; j < 4; ++j) { const int n = (lane >> 3) + 8 * j; const LAS float* s = scr + (8 * c) * 33 + n;
        u32x4 o; o.x = pk2(s[0 * 33], s[1 * 33]); o.y = pk2(s[2 * 33], s[3 * 33]); o.z = pk2(s[4 * 33], s[5 * 33]); o.w = pk2(s[6 * 33], s[7 * 33]);
        *(u32x4*)(WT + (size_t)dst_row<MODE>(n0 + n) * K + k0 + 8 * c) = o; }
    asm volatile("s_waitcnt lgkmcnt(0)" ::: "memory");
}
__device__ __forceinline__ void p0_mod_item(Frame& F, int item) {
    LAS float* sil = (LAS float*)F.lds;
    LAS float* red = (LAS float*)(F.lds + 40960);
    for (int i = F.tid; i < 9 * 1024; i += NTHREADS) { const int r = i >> 10, k = i & 1023; const float cv = r < 8 ? F.c[r * 1024 + k] : F.c_ctx[k]; sil[i] = cv / (1.f + expf(-cv)); }
    __syncthreads();
    const int n0 = item * 32, cq = F.tid & 7, kl = F.tid >> 3;
    float acc[9][4];
#pragma unroll
    for (int r = 0; r < 9; ++r)
#pragma unroll
        for (int j = 0; j < 4; ++j) acc[r][j] = 0.f;
    for (int k = kl; k < 1024; k += 64) {
        const f32x4 w = *(const f32x4*)(F.w_mod + (size_t)k * 6144 + n0 + 4 * cq);
#pragma unroll
        for (int r = 0; r < 9; ++r) { const float s = sil[r * 1024 + k]; acc[r][0] += s * w.x; acc[r][1] += s * w.y; acc[r][2] += s * w.z; acc[r][3] += s * w.w; }
    }
#pragma unroll
    for (int r = 0; r < 9; ++r)
#pragma unroll
        for (int j = 0; j < 4; ++j) { float v = acc[r][j]; v += __shfl_xor(v, 8); v += __shfl_xor(v, 16); v += __shfl_xor(v, 32); if (F.lane < 8) red[(F.wave * 8 + cq) * 36 + r * 4 + j] = v; }
    __syncthreads();
    if (F.tid < 288) { const int q = F.tid / 36, rj = F.tid % 36, r = rj >> 2, j = rj & 3; float s = 0.f;
#pragma unroll
        for (int w = 0; w < 8; ++w) s += red[(w * 8 + q) * 36 + rj];
        const int n = n0 + 4 * q + j; s += F.b_mod[n];
        if (r < 8) F.modx[r * 6144 + n] = s; else F.modc[n] = s; }
    __syncthreads();
}
__device__ __forceinline__ void p0_prologue(Frame& F) {
    if (F.vcu < 192) p0_mod_item(F, F.vcu);
    if (F.vcu == 255 || (F.G < 256 && F.vcu == F.G - 1)) {
        for (int i = F.tid; i < 1024; i += NTHREADS) { const int pos = i >> 4, f = i & 15; const float inv = powf(10000.f, -(float)f / 16.f); const float ang = (float)pos * inv;
            F.rope[2 * i] = cosf(ang); F.rope[2 * i + 1] = sinf(ang); }
    }
    LAS float* scr = (LAS float*)(F.lds + F.wave * 16384);
    const int gw = F.vcu * NWAVES + F.wave, NGW = F.G * NWAVES;
    constexpr int I_IN = 16 * 136, I_A = 8 * 32, I_OUT = 16 * 32, I_GU = 16 * 64, I_D = 16 * 32;
    constexpr int NITEMS = I_IN + 2 * I_A + I_OUT + NE * I_GU + NE * I_D;
    for (int it = gw; it < NITEMS; it += NGW) {
        int r = it;
        if (r < I_IN) { p0_transpose_item<0>(F.w_in, 1024, INC, F.win_t, scr, r, F.lane); continue; } r -= I_IN;
        if (r < I_A) { p0_transpose_item<0>(F.w_branch_a, 512, 1024, F.wa_t, scr, r, F.lane); continue; } r -= I_A;
        if (r < I_A) { p0_transpose_item<0>(F.w_branch_b, 512, 1024, F.wb_t, scr, r, F.lane); continue; } r -= I_A;
        if (r < I_OUT) { p0_transpose_item<0>(F.w_out, 1024, 1024, F.wout_t, scr, r, F.lane); continue; } r -= I_OUT;
        if (r < NE * I_GU) { const int e = r / I_GU; p0_transpose_item<1>(F.w_gate_up + (size_t)e * 1024 * 2048, 1024, 2048, F.wgu_t + (size_t)e * 2048 * 1024, scr, r % I_GU, F.lane); continue; } r -= NE * I_GU;
        { const int e = r / I_D; p0_transpose_item<0>(F.w_down + (size_t)e * 1024 * 1024, 1024, 1024, F.wd_t + (size_t)e * 1024 * 1024, scr, r % I_D, F.lane); }
    }
}

__device__ __forceinline__ void p1_prenorm(Frame& F) {
    const int gw = F.vcu * NWAVES + F.wave, NGW = F.G * NWAVES;
    for (int m = gw; m < MA; m += NGW) {
        const float* xrow = m < MT ? F.x + (size_t)m * DM : F.ctx + (size_t)(m - MT) * DM;
        const float* sh = m < MT ? F.modx + (m / SEQ) * 6144 : F.modc;
        const float* sc = sh + 1024;
        f32x4 v[4]; float s = 0.f;
#pragma unroll
        for (int j = 0; j < 4; ++j) { v[j] = ((const f32x4*)xrow)[F.lane + 64 * j]; s += (v[j].x * v[j].x + v[j].y * v[j].y) + (v[j].z * v[j].z + v[j].w * v[j].w); }
        const float rs = 1.f / sqrtf(wave_sum(s) * (1.f / DM) + NORM_EPS);
        unsigned long long* o8 = (unsigned long long*)(F.xn + (size_t)m * DM) + F.lane;
#pragma unroll
        for (int j = 0; j < 4; ++j) { const int q = F.lane + 64 * j; const f32x4 g = ((const f32x4*)F.g_pre_mix)[q], a = ((const f32x4*)sh)[q], b = ((const f32x4*)sc)[q];
            const float h0 = v[j].x * rs * g.x * (1.f + b.x) + a.x, h1 = v[j].y * rs * g.y * (1.f + b.y) + a.y, h2 = v[j].z * rs * g.z * (1.f + b.z) + a.z, h3 = v[j].w * rs * g.w * (1.f + b.w) + a.w;
            o8[64 * j] = (unsigned long long)pk2(h0, h1) | ((unsigned long long)pk2(h2, h3) << 32); }
    }
}

__device__ __forceinline__ void wave_gemm_32x32(f32x4 (&acc)[2][2], const bf16* a0, const bf16* a1, const bf16* b0, const bf16* b1, int K, int fq) {
#pragma unroll 4
    for (int k = 0; k < K; k += 32) {
        const bf16x8 A0 = *(const bf16x8*)(a0 + k + 8 * fq), A1 = *(const bf16x8*)(a1 + k + 8 * fq);
        const bf16x8 B0 = *(const bf16x8*)(b0 + k + 8 * fq), B1 = *(const bf16x8*)(b1 + k + 8 * fq);
        acc[0][0] = __builtin_amdgcn_mfma_f32_16x16x32_bf16(B0, A0, acc[0][0], 0, 0, 0);
        acc[0][1] = __builtin_amdgcn_mfma_f32_16x16x32_bf16(B1, A0, acc[0][1], 0, 0, 0);
        acc[1][0] = __builtin_amdgcn_mfma_f32_16x16x32_bf16(B0, A1, acc[1][0], 0, 0, 0);
        acc[1][1] = __builtin_amdgcn_mfma_f32_16x16x32_bf16(B1, A1, acc[1][1], 0, 0, 0);
    }
}
__device__ __forceinline__ void zero_acc(f32x4 (&acc)[2][2]) {
#pragma unroll
    for (int i = 0; i < 2; ++i)
#pragma unroll
        for (int j = 0; j < 2; ++j) acc[i][j] = (f32x4){0.f, 0.f, 0.f, 0.f};
}
__device__ __forceinline__ void st4bf(bf16* p, float a, float b, float c, float d) { u32x2 w; w.x = pk2(a, b); w.y = pk2(c, d); *(u32x2*)p = w; }

__device__ __forceinline__ void p2_epilogue_tile(Frame& F, const f32x4 (&acc)[2][2], int r0, int c0, int fr, int fq) {
#pragma unroll
    for (int i = 0; i < 2; ++i) {
        const int row = r0 + 16 * i + fr; const bool is_ctx = row >= MT; const int t = row & (SEQ - 1);
        f32x4 v0 = acc[i][0], v1 = acc[i][1];
        if (c0 < C_VA) {
            if (!is_ctx) { const int axis = (c0 >> 5) & 1, pos = axis ? (t & 63) : (t >> 6); const float* rp = F.rope + (pos * 16 + 4 * fq) * 2;
#pragma unroll
                for (int e = 0; e < 4; ++e) { const float cs = rp[2 * e], sn = rp[2 * e + 1], x1 = v0[e], x2 = v1[e]; v0[e] = x1 * cs - x2 * sn; v1[e] = x2 * cs + x1 * sn; } }
            if (c0 < C_KA) { v0 = v0 * 0.125f; v1 = v1 * 0.125f; }
        } else if (c0 < C_QB) {
        } else if (c0 < C_KB) { v0 = v0 * 0.125f; v1 = v1 * 0.125f;
        } else if (c0 < C_GA) {
        } else {
#pragma unroll
            for (int e = 0; e < 4; ++e) { v0[e] = sigmoidf_(v0[e]); v1[e] = sigmoidf_(v1[e]); }
        }
        bf16* o = F.p + (size_t)row * INC + c0 + 4 * fq;
        st4bf(o, v0[0], v0[1], v0[2], v0[3]); st4bf(o + 16, v1[0], v1[1], v1[2], v1[3]);
    }
}
__device__ __forceinline__ void p2_inproj_simple(Frame& F) {
    const int gw = F.vcu * NWAVES + F.wave, NGW = F.G * NWAVES, fr = F.lane & 15, fq = F.lane >> 4;
    constexpr int NCT = INC / 32, NRT_L = MT / 32, NCT_C = (256 + 1024) / 32;
    constexpr int NT = NRT_L * NCT + (MC / 32) * NCT_C;
    for (int tl = gw; tl < NT; tl += NGW) {
        int r0, c0;
        if (tl < NRT_L * NCT) { r0 = (tl / NCT) * 32; c0 = (tl % NCT) * 32; }
        else { const int u = tl - NRT_L * NCT; r0 = MT + (u / NCT_C) * 32; const int cc = u % NCT_C; c0 = cc < 8 ? C_KA + cc * 32 : C_KB + (cc - 8) * 32; }
        f32x4 acc[2][2]; zero_acc(acc);
        const bf16* a0 = F.xn + (size_t)(r0 + fr) * DM; const bf16* b0 = F.win_t + (size_t)(c0 + fr) * DM;
        wave_gemm_32x32(acc, a0, a0 + 16 * DM, b0, b0 + 16 * DM, DM, fq);
        p2_epilogue_tile(F, acc, r0, c0, fr, fq);
    }
}

__device__ __forceinline__ void attn_key(const float (&q)[64], const bf16* kp, const bf16* vp, float bias, float& m, float& l, float (&o)[64]) {
    float s = bias;
#pragma unroll
    for (int d8 = 0; d8 < 8; ++d8) { const u32x4 kk = *(const u32x4*)(kp + 8 * d8);
        s += q[8 * d8 + 0] * bf2f(kk.x & 0xffffu) + q[8 * d8 + 1] * bf2f(kk.x >> 16) + q[8 * d8 + 2] * bf2f(kk.y & 0xffffu) + q[8 * d8 + 3] * bf2f(kk.y >> 16)
           + q[8 * d8 + 4] * bf2f(kk.z & 0xffffu) + q[8 * d8 + 5] * bf2f(kk.z >> 16) + q[8 * d8 + 6] * bf2f(kk.w & 0xffffu) + q[8 * d8 + 7] * bf2f(kk.w >> 16); }
    const float mn = fmaxf(m, s), al = __expf(m - mn), pe = __expf(s - mn);
    l = l * al + pe; m = mn;
#pragma unroll
    for (int d8 = 0; d8 < 8; ++d8) { const u32x4 vv = *(const u32x4*)(vp + 8 * d8);
        o[8 * d8 + 0] = o[8 * d8 + 0] * al + pe * bf2f(vv.x & 0xffffu); o[8 * d8 + 1] = o[8 * d8 + 1] * al + pe * bf2f(vv.x >> 16);
        o[8 * d8 + 2] = o[8 * d8 + 2] * al + pe * bf2f(vv.y & 0xffffu); o[8 * d8 + 3] = o[8 * d8 + 3] * al + pe * bf2f(vv.y >> 16);
        o[8 * d8 + 4] = o[8 * d8 + 4] * al + pe * bf2f(vv.z & 0xffffu); o[8 * d8 + 5] = o[8 * d8 + 5] * al + pe * bf2f(vv.z >> 16);
        o[8 * d8 + 6] = o[8 * d8 + 6] * al + pe * bf2f(vv.w & 0xffffu); o[8 * d8 + 7] = o[8 * d8 + 7] * al + pe * bf2f(vv.w >> 16); }
}
__device__ __forceinline__ void p3_attn_naive(Frame& F) {
    const int gt = F.vcu * NTHREADS + F.tid, NGT = F.G * NTHREADS;
    for (int w = gt; w < 2 * 8 * MT; w += NGT) {
        const int br = w / (8 * MT), h = (w / MT) & 7, t = w % MT, b = t / SEQ, tl = t % SEQ;
        float q[64], o[64];
        const bf16* qp = F.p + (size_t)t * INC + (br ? C_QB : C_QA) + h * 64;
#pragma unroll
        for (int d = 0; d < 64; ++d) { q[d] = bf2f(qp[d]); o[d] = 0.f; }
        float m, l;
        if (br == 0) {
            const int kvh = h >> 2; m = F.a_sink[h]; l = 1.f;
            const int j0 = tl - 128 < 0 ? 0 : tl - 128, j1 = tl + 128 > SEQ - 1 ? SEQ - 1 : tl + 128;
            for (int j = j0; j <= j1; ++j) { const bf16* rp = F.p + (size_t)(b * SEQ + j) * INC; attn_key(q, rp + C_KA + kvh * 64, rp + C_VA + kvh * 64, 0.f, m, l, o); }
            for (int j = 0; j < CTXL; ++j) { const bf16* rp = F.p + (size_t)(MT + b * CTXL + j) * INC; attn_key(q, rp + C_KA + kvh * 64, rp + C_VA + kvh * 64, 0.f, m, l, o); }
        } else {
            m = -1e30f; l = 0.f;
            const int r = tl >> 6, c = tl & 63; int rs = r - 4; rs = rs < 0 ? 0 : (rs > 24 ? 24 : rs); int cs = c - 8; cs = cs < 0 ? 0 : (cs > 48 ? 48 : cs);
            for (int kr = rs; kr < rs + 8; ++kr)
                for (int kc = cs; kc < cs + 16; ++kc) { const bf16* rp = F.p + (size_t)(b * SEQ + kr * 64 + kc) * INC;
                    int dc = kc - c; dc = dc < -15 ? -15 : (dc > 15 ? 15 : dc);
                    const float bias = F.b_rpb[h * 15 * 31 + (kr - r + 7) * 31 + dc + 15];
                    attn_key(q, rp + C_KB + h * 64, rp + C_VB + h * 64, bias, m, l, o); }
            for (int j = 0; j < CTXL; ++j) { const bf16* rp = F.p + (size_t)(MT + b * CTXL + j) * INC; attn_key(q, rp + C_KB + h * 64, rp + C_VB + h * 64, 0.f, m, l, o); }
        }
        const float il = 1.f / l; bf16* op = F.yab + (size_t)t * DM + br * 512 + h * 64;
#pragma unroll
        for (int d = 0; d < 64; d += 4) st4bf(op + d, o[d] * il, o[d + 1] * il, o[d + 2] * il, o[d + 3] * il);
    }
}

__device__ __forceinline__ void p4_merge_simple(Frame& F) {
    const int gw = F.vcu * NWAVES + F.wave, NGW = F.G * NWAVES, fr = F.lane & 15, fq = F.lane >> 4;
    constexpr int NCT = DM / 32, NT = (MT / 32) * NCT;
    for (int tl = gw; tl < NT; tl += NGW) {
        const int r0 = (tl / NCT) * 32, c0 = (tl % NCT) * 32;
        f32x4 accA[2][2], accB[2][2]; zero_acc(accA); zero_acc(accB);
        const bf16* a0 = F.yab + (size_t)(r0 + fr) * DM;
        const bf16* ba = F.wa_t + (size_t)(c0 + fr) * 512; const bf16* bb = F.wb_t + (size_t)(c0 + fr) * 512;
        wave_gemm_32x32(accA, a0, a0 + 16 * DM, ba, ba + 16 * 512, 512, fq);
        wave_gemm_32x32(accB, a0 + 512, a0 + 512 + 16 * DM, bb, bb + 16 * 512, 512, fq);
#pragma unroll
        for (int i = 0; i < 2; ++i)
#pragma unroll
            for (int j = 0; j < 2; ++j) { const int row = r0 + 16 * i + fr, col = c0 + 16 * j + 4 * fq;
                const u32x2 ga = *(const u32x2*)(F.p + (size_t)row * INC + C_GA + col), gb = *(const u32x2*)(F.p + (size_t)row * INC + C_GB + col);
                const f32x4 a = accA[i][j], b = accB[i][j];
                st4bf(F.merged + (size_t)row * DM + col, bf2f(ga.x & 0xffffu) * a[0] + bf2f(gb.x & 0xffffu) * b[0], bf2f(ga.x >> 16) * a[1] + bf2f(gb.x >> 16) * b[1],
                      bf2f(ga.y & 0xffffu) * a[2] + bf2f(gb.y & 0xffffu) * b[2], bf2f(ga.y >> 16) * a[3] + bf2f(gb.y >> 16) * b[3]); }
    }
}
__device__ __forceinline__ void p5_outproj_simple(Frame& F) {
    const int gw = F.vcu * NWAVES + F.wave, NGW = F.G * NWAVES, fr = F.lane & 15, fq = F.lane >> 4;
    constexpr int NCT = DM / 32, NT = (MT / 32) * NCT;
    for (int tl = gw; tl < NT; tl += NGW) {
        const int r0 = (tl / NCT) * 32, c0 = (tl % NCT) * 32;
        f32x4 acc[2][2]; zero_acc(acc);
        const bf16* a0 = F.merged + (size_t)(r0 + fr) * DM; const bf16* b0 = F.wout_t + (size_t)(c0 + fr) * DM;
        wave_gemm_32x32(acc, a0, a0 + 16 * DM, b0, b0 + 16 * DM, DM, fq);
#pragma unroll
        for (int i = 0; i < 2; ++i)
#pragma unroll
            for (int j = 0; j < 2; ++j) { const f32x4 a = acc[i][j]; st4bf(F.mix + (size_t)(r0 + 16 * i + fr) * DM + c0 + 16 * j + 4 * fq, a[0], a[1], a[2], a[3]); }
    }
}

__device__ __forceinline__ void p6_row_router(Frame& F) {
    const int gw = F.vcu * NWAVES + F.wave, NGW = F.G * NWAVES;
    for (int m = gw; m < MT; m += NGW) {
        const float* md = F.modx + (m / SEQ) * 6144;
        f32x4 mx[4], xv[4]; float s = 0.f;
        const unsigned long long* mp = (const unsigned long long*)(F.mix + (size_t)m * DM) + F.lane;
#pragma unroll
        for (int j = 0; j < 4; ++j) { const unsigned long long w = mp[64 * j]; const unsigned lo = (unsigned)w, hi = (unsigned)(w >> 32);
            mx[j] = (f32x4){bf2f(lo & 0xffffu), bf2f(lo >> 16), bf2f(hi & 0xffffu), bf2f(hi >> 16)};
            s += (mx[j].x * mx[j].x + mx[j].y * mx[j].y) + (mx[j].z * mx[j].z + mx[j].w * mx[j].w); }
        const float r1 = 1.f / sqrtf(wave_sum(s) * (1.f / DM) + NORM_EPS);
        float s2 = 0.f;
#pragma unroll
        for (int j = 0; j < 4; ++j) { const int q = F.lane + 64 * j; const f32x4 x0 = ((const f32x4*)(F.x + (size_t)m * DM))[q], g = ((const f32x4*)F.g_post_mix)[q], g1 = ((const f32x4*)(md + 2048))[q];
            xv[j] = x0 + g1 * (mx[j] * r1 * g); ((f32x4*)(F.out + (size_t)m * DM))[q] = xv[j];
            s2 += (xv[j].x * xv[j].x + xv[j].y * xv[j].y) + (xv[j].z * xv[j].z + xv[j].w * xv[j].w); }
        const float r2 = 1.f / sqrtf(wave_sum(s2) * (1.f / DM) + NORM_EPS);
        unsigned long long* o8 = (unsigned long long*)(F.xn + (size_t)m * DM) + F.lane;
        float lg[32];
#pragma unroll
        for (int e = 0; e < 32; ++e) lg[e] = 0.f;
#pragma unroll
        for (int j = 0; j < 4; ++j) { const int q = F.lane + 64 * j; const f32x4 g = ((const f32x4*)F.g_pre_ffn)[q], sh = ((const f32x4*)(md + 3072))[q], sc = ((const f32x4*)(md + 4096))[q];
            const f32x4 h = xv[j] * r2 * g * (sc + 1.f) + sh;
            o8[64 * j] = (unsigned long long)pk2(h.x, h.y) | ((unsigned long long)pk2(h.z, h.w) << 32);
#pragma unroll
            for (int kk = 0; kk < 4; ++kk) { const float hv = h[kk]; const f32x4* wr = (const f32x4*)(F.w_router + (size_t)(4 * q + kk) * NE);
#pragma unroll
                for (int e4 = 0; e4 < 8; ++e4) { const f32x4 w = wr[e4]; lg[4 * e4] += hv * w.x; lg[4 * e4 + 1] += hv * w.y; lg[4 * e4 + 2] += hv * w.z; lg[4 * e4 + 3] += hv * w.w; } } }
#pragma unroll
        for (int e = 0; e < 32; ++e) lg[e] = wave_sum(lg[e]) + F.b_router[e];
        int ei[4]; float ev[4];
#pragma unroll
        for (int k = 0; k < 4; ++k) { float best = -INFINITY; int bi = 0;
#pragma unroll
            for (int e = 0; e < 32; ++e) if (lg[e] > best) { best = lg[e]; bi = e; }
#pragma unroll
            for (int e = 0; e < 32; ++e) if (e == bi) lg[e] = -INFINITY;
            ei[k] = bi; ev[k] = best; }
        const float w0 = 1.f, w1 = expf(ev[1] - ev[0]), w2 = expf(ev[2] - ev[0]), w3 = expf(ev[3] - ev[0]), inv = 1.f / (w0 + w1 + w2 + w3);
        if (F.lane < 4) { const int k = F.lane; const int e = k == 0 ? ei[0] : (k == 1 ? ei[1] : (k == 2 ? ei[2] : ei[3])); const float wv = (k == 0 ? w0 : (k == 1 ? w1 : (k == 2 ? w2 : w3))) * inv;
            const int pos = (int)__hip_atomic_fetch_add(F.ctl + CW_CNT + 64 * e, 1u, RLX_AGENT);
            F.tok[e * MT + pos] = m; F.tope[m * 4 + k] = e; F.topp[m * 4 + k] = pos; F.topw[m * 4 + k] = wv; }
    }
}

__device__ __forceinline__ void moe_tables(Frame& F, int RT) {
    LAS int* T = (LAS int*)(F.lds + TBL_OFF);
    if (F.tid == 0) { int pt = 0, pb = 0;
        for (int e = 0; e < NE; ++e) { const int n = (int)__hip_atomic_load(F.ctl + CW_CNT + 64 * e, RLX_AGENT); T[e] = n; T[32 + e] = pt; T[96 + e] = pb; pt += (n + RT - 1) / RT; pb += ((n + 255) / 256) * 256; }
        T[32 + NE] = pt; T[96 + NE] = pb; }
    __syncthreads();
}
__device__ __forceinline__ void p7_gateup_simple(Frame& F) {
    moe_tables(F, 32);
    const LAS int* T = (const LAS int*)(F.lds + TBL_OFF);
    const int gw = F.vcu * NWAVES + F.wave, NGW = F.G * NWAVES, fr = F.lane & 15, fq = F.lane >> 4;
    const int NT = T[32 + NE] * 64;
    for (int tl = gw; tl < NT; tl += NGW) {
        const int rt = tl >> 6, ct = tl & 63; int e = 0;
        while (e < NE - 1 && T[32 + e + 1] <= rt) ++e;
        const int n = T[e], p0 = (rt - T[32 + e]) * 32, base = T[96 + e];
        const int pa = p0 + fr, pb = p0 + 16 + fr;
        const int ta = F.tok[e * MT + (pa < n ? pa : 0)], tb = F.tok[e * MT + (pb < n ? pb : 0)];
        f32x4 acc[2][2]; zero_acc(acc);
        const bf16* b0 = F.wgu_t + ((size_t)e * 2048 + ct * 32 + fr) * DM;
        wave_gemm_32x32(acc, F.xn + (size_t)ta * DM, F.xn + (size_t)tb * DM, b0, b0 + 16 * DM, DM, fq);
        const int jg = ct * 16 + 4 * fq; const f32x4 bg = *(const f32x4*)(F.b_gate_up + (size_t)e * 2048 + jg), bu = *(const f32x4*)(F.b_gate_up + (size_t)e * 2048 + 1024 + jg);
#pragma unroll
        for (int i = 0; i < 2; ++i) { float r[4];
#pragma unroll
            for (int q = 0; q < 4; ++q) { float g = acc[i][0][q] + bg[q], u = acc[i][1][q] + bu[q]; g = fminf(g, 7.f); u = fminf(fmaxf(u, -7.f), 7.f); r[q] = (u + 1.f) * (g * sigmoidf_(1.702f * g)); }
            st4bf(F.act + (size_t)(base + p0 + 16 * i + fr) * DE + jg, r[0], r[1], r[2], r[3]); }
    }
}
__device__ __forceinline__ void p8_down_simple(Frame& F) {
    moe_tables(F, 32);
    const LAS int* T = (const LAS int*)(F.lds + TBL_OFF);
    const int gw = F.vcu * NWAVES + F.wave, NGW = F.G * NWAVES, fr = F.lane & 15, fq = F.lane >> 4;
    const int NT = T[32 + NE] * 32;
    for (int tl = gw; tl < NT; tl += NGW) {
        const int rt = tl >> 5, ct = tl & 31; int e = 0;
        while (e < NE - 1 && T[32 + e + 1] <= rt) ++e;
        const int p0 = (rt - T[32 + e]) * 32, base = T[96 + e];
        f32x4 acc[2][2]; zero_acc(acc);
        const bf16* a0 = F.act + (size_t)(base + p0 + fr) * DE; const bf16* b0 = F.wd_t + ((size_t)e * 1024 + ct * 32 + fr) * DE;
        wave_gemm_32x32(acc, a0, a0 + 16 * DE, b0, b0 + 16 * DE, DE, fq);
#pragma unroll
        for (int i = 0; i < 2; ++i)
#pragma unroll
            for (int j = 0; j < 2; ++j) { const int col = ct * 32 + 16 * j + 4 * fq; const f32x4 bd = *(const f32x4*)(F.b_down + (size_t)e * 1024 + col); const f32x4 a = acc[i][j] + bd;
                st4bf(F.y + (size_t)(base + p0 + 16 * i + fr) * DM + col, a[0], a[1], a[2], a[3]); }
    }
}
__device__ __forceinline__ void p9_final(Frame& F) {
    moe_tables(F, 32);
    const LAS int* T = (const LAS int*)(F.lds + TBL_OFF);
    const int gw = F.vcu * NWAVES + F.wave, NGW = F.G * NWAVES;
    for (int m = gw; m < MT; m += NGW) {
        const float* md = F.modx + (m / SEQ) * 6144;
        f32x4 f[4];
#pragma unroll
        for (int j = 0; j < 4; ++j) f[j] = (f32x4){0.f, 0.f, 0.f, 0.f};
#pragma unroll
        for (int k = 0; k < 4; ++k) { const int e = F.tope[m * 4 + k], pos = F.topp[m * 4 + k]; const float wv = F.topw[m * 4 + k];
            const unsigned long long* yp = (const unsigned long long*)(F.y + (size_t)(T[96 + e] + pos) * DM) + F.lane;
#pragma unroll
            for (int j = 0; j < 4; ++j) { const unsigned long long w = yp[64 * j]; const unsigned lo = (unsigned)w, hi = (unsigned)(w >> 32);
                f[j] += (f32x4){bf2f(lo & 0xffffu), bf2f(lo >> 16), bf2f(hi & 0xffffu), bf2f(hi >> 16)} * wv; } }
        float s = 0.f;
#pragma unroll
        for (int j = 0; j < 4; ++j) s += (f[j].x * f[j].x + f[j].y * f[j].y) + (f[j].z * f[j].z + f[j].w * f[j].w);
        const float rs = 1.f / sqrtf(wave_sum(s) * (1.f / DM) + NORM_EPS);
#pragma unroll
        for (int j = 0; j < 4; ++j) { const int q = F.lane + 64 * j; const f32x4 g = ((const f32x4*)F.g_post_ffn)[q], g2 = ((const f32x4*)(md + 5120))[q];
            f32x4* op = (f32x4*)(F.out + (size_t)m * DM) + q; *op = *op + g2 * (f[j] * rs * g); }
    }
}


namespace pg8 {
constexpr int BM = 256, BK = 64, HALF = 128, HTB = HALF * BK * 2, STAGE_BYTES = 8 * HTB, NXCD = 8, WGM = 8;
__device__ __forceinline__ int lds_byte(int r, int c) { const int st = (r >> 4) * 2 + (c >> 5), rr = r & 15, cc = c & 31, ob = rr * 64 + cc * 2; return st * 1024 + (ob ^ (((ob >> 9) & 1) << 5)); }
__device__ __forceinline__ void stage_rc(int b, int& R, int& C) { const int st = b / 1024, sb = b % 1024, swz = sb ^ (((sb >> 9) & 1) << 5); R = (st >> 1) * 16 + swz / 64; C = (st & 1) * 32 + (swz % 64) / 2; }
__device__ __forceinline__ int perm32(int rho) { const int n = rho >> 4, i = rho & 15; return 8 * (i >> 2) + 4 * n + (i & 3); }
struct Unit { int pm, pn, ex; };
__device__ __forceinline__ void map_tile(int L, int nM, int nN, int& pm, int& pn) {
    const int nwg = nM * nN; int wgid = L;
    { const int q = nwg / NXCD, r = nwg % NXCD, xcd = wgid % NXCD, off = wgid / NXCD; wgid = (xcd < r ? xcd * (q + 1) : r * (q + 1) + (xcd - r) * q) + off; }
    const int nig = WGM * nN, gid = wgid / nig, fm = gid * WGM, gsz = (nM - fm) < WGM ? (nM - fm) : WGM;
    pm = fm + ((wgid % nig) % gsz); pn = (wgid % nig) / gsz;
}
__device__ __forceinline__ unsigned cvt_pk_bf16(float lo, float hi) { unsigned r; asm volatile("v_cvt_pk_bf16_f32 %0, %1, %2" : "=v"(r) : "v"(lo), "v"(hi)); return r; }

template <class Epi, class Sched, bool GATHER, bool ALIGN_EPI>
__device__ __forceinline__ void gemm_phase(LAS unsigned char* lds, const int K, const int lda, const Sched& S, const Epi& E) {
    const int tid = threadIdx.x, wid = __builtin_amdgcn_readfirstlane(tid >> 6), lane = tid & 63, wr = wid >> 2, wc = wid & 3, fr = lane & 15, fq = lane >> 4;
    const int nt = K / BK;
    int RA[2], CA[2]; unsigned voffB[2];
#pragma unroll
    for (int i = 0; i < 2; ++i) { int R, C; stage_rc(tid * 16 + i * 8192, R, C); RA[i] = R; CA[i] = C; const int Rb = Epi::PERM ? ((R & ~31) + perm32(R & 31)) : R; voffB[i] = (unsigned)(Rb * K + C) * 2u; }
    const size_t kstep = (size_t)(BK * 2);
    const size_t hstepB = (size_t)HALF * K * 2;
    const unsigned ldsw = (unsigned)wid * 1024u;
    const int aoff = lds_byte(wr * 64 + fr, fq * 8), boff = lds_byte(wc * 32 + fr, fq * 8);
    unsigned OC[2][2], ON[2][2];
#define PG8_SETOFF(O, ui) do { _Pragma("unroll") for (int _h = 0; _h < 2; ++_h) _Pragma("unroll") for (int _i = 0; _i < 2; ++_i) { \
        if constexpr (GATHER) O[_h][_i] = (unsigned)S.tok_row((ui), _h * HALF + RA[_i]) * (unsigned)(lda * 2) + (unsigned)CA[_i] * 2u; \
        else O[_h][_i] = (unsigned)((_h * HALF + RA[_i]) * lda + CA[_i]) * 2u; } } while (0)
#define PG8_SA(b, h) (((b) * 2 + (h)) * HTB)
#define PG8_SB(b, h) ((4 + (b) * 2 + (h)) * HTB)
#define PG8_STAGEA(bufoff, gbase, O, h) do { _Pragma("unroll") for (int _i = 0; _i < 2; ++_i) \
        __builtin_amdgcn_global_load_lds((const unsigned*)((const char*)(gbase) + (O)[h][_i]), (LAS unsigned*)(lds + (bufoff) + ldsw + _i * 8192), 16, 0, 0); } while (0)
#define PG8_STAGEB(bufoff, gbase) do { _Pragma("unroll") for (int _i = 0; _i < 2; ++_i) \
        __builtin_amdgcn_global_load_lds((const unsigned*)((const char*)(gbase) + voffB[_i]), (LAS unsigned*)(lds + (bufoff) + ldsw + _i * 8192), 16, 0, 0); } while (0)
#define PG8_LDA(dst, b, h) do { _Pragma("unroll") for (int m = 0; m < 4; ++m) _Pragma("unroll") for (int k = 0; k < 2; ++k) dst[m][k] = *(const LAS bf16x8*)(lds + PG8_SA(b, h) + aoff + m * 2048 + k * 1024); } while (0)
#define PG8_LDB(dst, b, h) do { _Pragma("unroll") for (int n = 0; n < 2; ++n) _Pragma("unroll") for (int k = 0; k < 2; ++k) dst[n][k] = *(const LAS bf16x8*)(lds + PG8_SB(b, h) + boff + n * 2048 + k * 1024); } while (0)
#define PG8_MMA(ai, bj, At, Bt) do { __builtin_amdgcn_s_setprio(1); _Pragma("unroll") for (int m = 0; m < 4; ++m) _Pragma("unroll") for (int n = 0; n < 2; ++n) _Pragma("unroll") for (int k = 0; k < 2; ++k) \
        acc[ai][bj][m][n] = __builtin_amdgcn_mfma_f32_16x16x32_bf16(Bt[n][k], At[m][k], acc[ai][bj][m][n], 0, 0, 0); __builtin_amdgcn_s_setprio(0); } while (0)
#define PG8_WAIT_V(n) asm volatile("s_waitcnt vmcnt(" #n ")" ::: "memory")
#define PG8_WAIT_L(n) asm volatile("s_waitcnt lgkmcnt(" #n ")" ::: "memory")
#define PG8_BAR __builtin_amdgcn_s_barrier()
#define PG8_SCHED __builtin_amdgcn_sched_barrier(0)
    Unit cur, nxt; int ui = 0;
    if (!S.next(0, cur)) return;
    PG8_SETOFF(OC, 0);
    f32x4 acc[2][2][4][2];
#pragma unroll
    for (int a = 0; a < 2; ++a)
#pragma unroll
        for (int b = 0; b < 2; ++b)
#pragma unroll
            for (int m = 0; m < 4; ++m)
#pragma unroll
                for (int n = 0; n < 2; ++n) acc[a][b][m][n] = (f32x4){0.f, 0.f, 0.f, 0.f};
    bf16x8 At[4][2], B0[2][2], B1[2][2];
    const char* cA = S.a_base(cur); const char* cB = S.b_base(cur);
    PG8_STAGEB(PG8_SB(0, 0), cB); PG8_STAGEB(PG8_SB(0, 1), cB + hstepB); PG8_STAGEA(PG8_SA(0, 0), cA, OC, 0); PG8_STAGEA(PG8_SA(0, 1), cA, OC, 1);
    if (wr == 1) PG8_BAR;
    PG8_WAIT_V(2); PG8_BAR;
    PG8_STAGEB(PG8_SB(1, 0), cB + kstep); PG8_STAGEA(PG8_SA(1, 0), cA + kstep, OC, 0); PG8_STAGEB(PG8_SB(1, 1), cB + hstepB + kstep);
    PG8_WAIT_V(6); PG8_BAR;
    for (;;) {
        const bool has_next = S.next(ui + 1, nxt);
        const char* nA = has_next ? S.a_base(nxt) : cA; const char* nB = has_next ? S.b_base(nxt) : cB;
        if constexpr (GATHER) { if (has_next) { PG8_SETOFF(ON, ui + 1); } else {
#pragma unroll
            for (int h = 0; h < 2; ++h)
#pragma unroll
                for (int i = 0; i < 2; ++i) ON[h][i] = OC[h][i]; } }
        for (int t = 0; t < nt; t += 2) {
            const bool last = (t == nt - 2);
            const char* a1 = cA + (size_t)(t + 1) * kstep;
            const char* a2 = last ? nA : cA + (size_t)(t + 2) * kstep; const char* b2 = last ? nB : cB + (size_t)(t + 2) * kstep;
            const char* a3 = a2 + kstep; const char* b3 = b2 + kstep;
            unsigned O2[2][2];
#pragma unroll
            for (int h = 0; h < 2; ++h)
#pragma unroll
                for (int i = 0; i < 2; ++i) O2[h][i] = (GATHER && last) ? ON[h][i] : OC[h][i];
            PG8_LDB(B0, 0, 0); PG8_LDB(B1, 0, 1); PG8_SCHED; PG8_LDA(At, 0, 0); PG8_STAGEA(PG8_SA(1, 1), a1, OC, 1);
            PG8_WAIT_V(8); PG8_WAIT_L(0); PG8_BAR; PG8_MMA(0, 0, At, B0); PG8_MMA(0, 1, At, B1); PG8_BAR; PG8_SCHED;
            PG8_LDA(At, 0, 1); PG8_STAGEB(PG8_SB(0, 0), b2); PG8_STAGEB(PG8_SB(0, 1), b2 + hstepB); PG8_STAGEA(PG8_SA(0, 0), a2, O2, 0);
            PG8_WAIT_V(8); PG8_WAIT_L(0); PG8_BAR; PG8_MMA(1, 0, At, B0); PG8_MMA(1, 1, At, B1); PG8_BAR; PG8_SCHED;
            PG8_LDB(B0, 1, 0); PG8_LDB(B1, 1, 1); PG8_SCHED; PG8_LDA(At, 1, 0); PG8_STAGEA(PG8_SA(0, 1), a2, O2, 1);
            PG8_WAIT_V(8); PG8_WAIT_L(0); PG8_BAR; PG8_MMA(0, 0, At, B0); PG8_MMA(0, 1, At, B1); PG8_BAR; PG8_SCHED;
            PG8_LDA(At, 1, 1); PG8_STAGEB(PG8_SB(1, 0), b3); PG8_STAGEB(PG8_SB(1, 1), b3 + hstepB); PG8_STAGEA(PG8_SA(1, 0), a3, O2, 0);
            PG8_WAIT_V(8); PG8_WAIT_L(0); PG8_BAR; PG8_MMA(1, 0, At, B0); PG8_MMA(1, 1, At, B1); PG8_BAR; PG8_SCHED;
        }
        if constexpr (ALIGN_EPI) { if (wr == 0) PG8_BAR; }
        E(acc, cur, wr, wc, fr, fq);
        if (!has_next) break;
#pragma unroll
        for (int a = 0; a < 2; ++a)
#pragma unroll
            for (int b = 0; b < 2; ++b)
#pragma unroll
                for (int m = 0; m < 4; ++m)
#pragma unroll
                    for (int n = 0; n < 2; ++n) acc[a][b][m][n] = (f32x4){0.f, 0.f, 0.f, 0.f};
        cur = nxt; cA = nA; cB = nB; ++ui;
        if constexpr (GATHER) {
#pragma unroll
            for (int h = 0; h < 2; ++h)
#pragma unroll
                for (int i = 0; i < 2; ++i) OC[h][i] = ON[h][i]; }
        if constexpr (ALIGN_EPI) { if (wr == 1) PG8_BAR; }
    }
    PG8_WAIT_V(0);
    if constexpr (!ALIGN_EPI) { if (wr == 0) PG8_BAR; }
    PG8_BAR;
#undef PG8_SETOFF
#undef PG8_SA
#undef PG8_SB
#undef PG8_STAGEA
#undef PG8_STAGEB
#undef PG8_LDA
#undef PG8_LDB
#undef PG8_MMA
#undef PG8_WAIT_V
#undef PG8_WAIT_L
#undef PG8_BAR
#undef PG8_SCHED
}

struct InProjOrder {
    const char* A; const char* Bt; int G, c;
    __device__ __forceinline__ bool next(int i, Unit& u) const {
        const int L = i * G + c; if (L >= 64 * 17 + 40) return false; u.ex = 0;
        if (L < 64 * 17) { map_tile(L, 64, 17, u.pm, u.pn); return true; }
        const int uu = L - 64 * 17; u.pm = 64 + (uu & 7); const int j = uu >> 3; u.pn = j == 0 ? 2 : 4 + j; return true;
    }
    __device__ __forceinline__ const char* a_base(const Unit& u) const { return A + (size_t)u.pm * (256 * DM * 2); }
    __device__ __forceinline__ const char* b_base(const Unit& u) const { return Bt + (size_t)u.pn * (256 * DM * 2); }
};
struct MergeOrder {
    const char* yab; const char* wa; const char* wb; int G, c;
    __device__ __forceinline__ bool next(int i, Unit& u) const { const int L = i * G + c; if (L >= 512) return false; u.ex = L >> 8; map_tile(L & 255, 64, 4, u.pm, u.pn); return true; }
    __device__ __forceinline__ const char* a_base(const Unit& u) const { return yab + ((size_t)u.pm * 256 * DM + u.ex * 512) * 2; }
    __device__ __forceinline__ const char* b_base(const Unit& u) const { return (u.ex ? wb : wa) + (size_t)u.pn * (256 * 512 * 2); }
};
struct DenseOrder {
    const char* A; const char* Bt; int nM, nN, G, c;
    __device__ __forceinline__ bool next(int i, Unit& u) const { const int L = i * G + c; if (L >= nM * nN) return false; u.ex = 0; map_tile(L, nM, nN, u.pm, u.pn); return true; }
    __device__ __forceinline__ const char* a_base(const Unit& u) const { return A + (size_t)u.pm * (256 * DM * 2); }
    __device__ __forceinline__ const char* b_base(const Unit& u) const { return Bt + (size_t)u.pn * (256 * DM * 2); }
};
struct MoeOrder {
    const LAS int* T; const LAS int* tokc; const char* A; const char* Bt; int nN, brows, G, c; bool gather;
    __device__ __forceinline__ bool next(int i, Unit& u) const {
        const int Tm = T[32 + NE]; const int L = i * G + c; if (L >= Tm * nN) return false;
        map_tile(L, Tm, nN, u.pm, u.pn); int e = 0; while (e < NE - 1 && T[32 + e + 1] <= u.pm) ++e; u.ex = e; return true;
    }
    __device__ __forceinline__ const char* a_base(const Unit& u) const { return gather ? A : A + (size_t)u.pm * (256 * DM * 2); }
    __device__ __forceinline__ const char* b_base(const Unit& u) const { return Bt + ((size_t)u.ex * brows + (size_t)u.pn * 256) * (DM * 2); }
    __device__ __forceinline__ int tok_row(int ui, int r) const { return tokc[ui * 256 + r]; }
};
}

__device__ __forceinline__ void inproj_xform(const float* rope, int row, int c0, int fq, f32x4& v0, f32x4& v1) {
    const bool is_ctx = row >= MT; const int t = row & (SEQ - 1);
    if (c0 < C_VA) {
        if (!is_ctx) { const int axis = (c0 >> 5) & 1, pos = axis ? (t & 63) : (t >> 6); const float* rp = rope + (pos * 16 + 4 * fq) * 2;
            const f32x4 r0 = *(const f32x4*)rp, r1 = *(const f32x4*)(rp + 4);
            const float cs[4] = {r0[0], r0[2], r1[0], r1[2]}, sn[4] = {r0[1], r0[3], r1[1], r1[3]};
#pragma unroll
            for (int e = 0; e < 4; ++e) { const float x1 = v0[e], x2 = v1[e]; v0[e] = x1 * cs[e] - x2 * sn[e]; v1[e] = x2 * cs[e] + x1 * sn[e]; } }
        if (c0 < C_KA) { v0 = v0 * 0.125f; v1 = v1 * 0.125f; }
    } else if (c0 < C_QB) {
    } else if (c0 < C_KB) { v0 = v0 * 0.125f; v1 = v1 * 0.125f;
    } else if (c0 < C_GA) {
    } else {
#pragma unroll
        for (int e = 0; e < 4; ++e) { v0[e] = sigmoidf_(v0[e]); v1[e] = sigmoidf_(v1[e]); }
    }
}
struct EpiInProj {
    static constexpr bool PERM = false;
    bf16* P; const float* rope;
    __device__ __forceinline__ void operator()(const f32x4 (&acc)[2][2][4][2], const pg8::Unit& u, int wr, int wc, int fr, int fq) const {
#pragma unroll
        for (int ai = 0; ai < 2; ++ai)
#pragma unroll
            for (int m = 0; m < 4; ++m) { const int row = u.pm * 256 + ai * 128 + wr * 64 + m * 16 + fr;
#pragma unroll
                for (int bj = 0; bj < 2; ++bj) { const int c0 = u.pn * 256 + bj * 128 + wc * 32; f32x4 v0 = acc[ai][bj][m][0], v1 = acc[ai][bj][m][1];
                    inproj_xform(rope, row, c0, fq, v0, v1);
                    bf16* o = P + (size_t)row * INC + c0 + 4 * fq; u32x2 w0, w1; w0.x = pg8::cvt_pk_bf16(v0[0], v0[1]); w0.y = pg8::cvt_pk_bf16(v0[2], v0[3]); w1.x = pg8::cvt_pk_bf16(v1[0], v1[1]); w1.y = pg8::cvt_pk_bf16(v1[2], v1[3]);
                    *(u32x2*)o = w0; *(u32x2*)(o + 16) = w1; } }
    }
};
struct EpiMerge {
    static constexpr bool PERM = true;
    bf16* merged; const bf16* P;
    __device__ __forceinline__ void operator()(const f32x4 (&acc)[2][2][4][2], const pg8::Unit& u, int wr, int wc, int fr, int fq) const {
        const int gcol = u.ex ? C_GB : C_GA;
#pragma unroll
        for (int ai = 0; ai < 2; ++ai)
#pragma unroll
            for (int m = 0; m < 4; ++m) { const int row = u.pm * 256 + ai * 128 + wr * 64 + m * 16 + fr;
#pragma unroll
                for (int bj = 0; bj < 2; ++bj) { const int col0 = u.pn * 256 + bj * 128 + wc * 32 + 8 * fq; const f32x4 v0 = acc[ai][bj][m][0], v1 = acc[ai][bj][m][1];
                    const u32x4 g = *(const u32x4*)(P + (size_t)row * INC + gcol + col0); bf16* op = merged + (size_t)row * DM + col0;
                    float r[8] = {bf2f(g.x & 0xffffu) * v0[0], bf2f(g.x >> 16) * v0[1], bf2f(g.y & 0xffffu) * v0[2], bf2f(g.y >> 16) * v0[3],
                                  bf2f(g.z & 0xffffu) * v1[0], bf2f(g.z >> 16) * v1[1], bf2f(g.w & 0xffffu) * v1[2], bf2f(g.w >> 16) * v1[3]};
                    if (u.ex) { const u32x4 o = *(const u32x4*)op; r[0] += bf2f(o.x & 0xffffu); r[1] += bf2f(o.x >> 16); r[2] += bf2f(o.y & 0xffffu); r[3] += bf2f(o.y >> 16);
                        r[4] += bf2f(o.z & 0xffffu); r[5] += bf2f(o.z >> 16); r[6] += bf2f(o.w & 0xffffu); r[7] += bf2f(o.w >> 16); }
                    u32x4 w; w.x = pg8::cvt_pk_bf16(r[0], r[1]); w.y = pg8::cvt_pk_bf16(r[2], r[3]); w.z = pg8::cvt_pk_bf16(r[4], r[5]); w.w = pg8::cvt_pk_bf16(r[6], r[7]);
                    *(u32x4*)op = w; } }
    }
};
struct EpiBf16 {
    static constexpr bool PERM = true;
    bf16* O; int ldc; const float* bias; int bias_estride;
    __device__ __forceinline__ void operator()(const f32x4 (&acc)[2][2][4][2], const pg8::Unit& u, int wr, int wc, int fr, int fq) const {
        const int row0 = u.pm * 256 + wr * 64 + fr, col0 = u.pn * 256 + wc * 32 + 8 * fq;
        f32x4 bv[2][2];
#pragma unroll
        for (int bj = 0; bj < 2; ++bj)
#pragma unroll
            for (int n = 0; n < 2; ++n) bv[bj][n] = bias ? *(const f32x4*)(bias + (size_t)u.ex * bias_estride + col0 + bj * 128 + 4 * n) : (f32x4){0.f, 0.f, 0.f, 0.f};
#pragma unroll
        for (int ai = 0; ai < 2; ++ai)
#pragma unroll
            for (int m = 0; m < 4; ++m) { bf16* rowp = O + (size_t)(row0 + ai * 128 + m * 16) * ldc + col0;
#pragma unroll
                for (int bj = 0; bj < 2; ++bj) { const f32x4 v0 = acc[ai][bj][m][0] + bv[bj][0], v1 = acc[ai][bj][m][1] + bv[bj][1];
                    u32x4 w; w.x = pg8::cvt_pk_bf16(v0[0], v0[1]); w.y = pg8::cvt_pk_bf16(v0[2], v0[3]); w.z = pg8::cvt_pk_bf16(v1[0], v1[1]); w.w = pg8::cvt_pk_bf16(v1[2], v1[3]);
                    *(u32x4*)(rowp + bj * 128) = w; } }
    }
};
struct EpiGateUp {
    static constexpr bool PERM = false;
    bf16* act; const float* bgu;
    __device__ __forceinline__ void operator()(const f32x4 (&acc)[2][2][4][2], const pg8::Unit& u, int wr, int wc, int fr, int fq) const {
        f32x4 bg[2], bu[2]; int jg[2];
#pragma unroll
        for (int bj = 0; bj < 2; ++bj) { jg[bj] = 16 * (u.pn * 8 + bj * 4 + wc) + 4 * fq; bg[bj] = *(const f32x4*)(bgu + (size_t)u.ex * 2048 + jg[bj]); bu[bj] = *(const f32x4*)(bgu + (size_t)u.ex * 2048 + 1024 + jg[bj]); }
#pragma unroll
        for (int ai = 0; ai < 2; ++ai)
#pragma unroll
            for (int m = 0; m < 4; ++m) { const int row = u.pm * 256 + ai * 128 + wr * 64 + m * 16 + fr;
#pragma unroll
                for (int bj = 0; bj < 2; ++bj) { float r[4];
#pragma unroll
                    for (int q = 0; q < 4; ++q) { float g = acc[ai][bj][m][0][q] + bg[bj][q], uu = acc[ai][bj][m][1][q] + bu[bj][q]; g = fminf(g, 7.f); uu = fminf(fmaxf(uu, -7.f), 7.f); r[q] = (uu + 1.f) * (g * sigmoidf_(1.702f * g)); }
                    u32x2 w; w.x = pg8::cvt_pk_bf16(r[0], r[1]); w.y = pg8::cvt_pk_bf16(r[2], r[3]); *(u32x2*)(act + (size_t)row * DE + jg[bj]) = w; } }
    }
};

__device__ __forceinline__ void p2_inproj_fast(Frame& F) {
    pg8::InProjOrder S{(const char*)F.xn, (const char*)F.win_t, F.G, (int)blockIdx.x}; EpiInProj E{F.p, F.rope};
    pg8::gemm_phase<EpiInProj, pg8::InProjOrder, false, true>(F.lds, DM, DM, S, E);
}
__device__ __forceinline__ void p4_merge_fast(Frame& F) {
    pg8::MergeOrder S{(const char*)F.yab, (const char*)F.wa_t, (const char*)F.wb_t, F.G, (int)blockIdx.x}; EpiMerge E{F.merged, F.p};
    pg8::gemm_phase<EpiMerge, pg8::MergeOrder, false, true>(F.lds, 512, DM, S, E);
}
__device__ __forceinline__ void p5_outproj_fast(Frame& F) {
    pg8::DenseOrder S{(const char*)F.merged, (const char*)F.wout_t, 64, 4, F.G, (int)blockIdx.x}; EpiBf16 E{F.mix, DM, nullptr, 0};
    pg8::gemm_phase<EpiBf16, pg8::DenseOrder, false, true>(F.lds, DM, DM, S, E);
}
__device__ __forceinline__ void p7_gateup_fast(Frame& F) {
    moe_tables(F, 256);
    const LAS int* T = (const LAS int*)(F.lds + TBL_OFF); LAS int* tokc = (LAS int*)(F.lds + TOKC_OFF);
    pg8::MoeOrder S{T, tokc, (const char*)F.xn, (const char*)F.wgu_t, 8, 2048, F.G, (int)blockIdx.x, true};
    for (int i = 0; i < 9; ++i) { pg8::Unit u; if (!S.next(i, u)) break;
        if (F.tid < 256) { const int e = u.ex, pos = (u.pm - T[32 + e]) * 256 + F.tid, n = T[e]; tokc[i * 256 + F.tid] = F.tok[e * MT + (pos < n ? pos : 0)]; } }
    __syncthreads();
    EpiGateUp E{F.act, F.b_gate_up};
    pg8::gemm_phase<EpiGateUp, pg8::MoeOrder, true, true>(F.lds, DM, DM, S, E);
}
__device__ __forceinline__ void p8_down_fast(Frame& F) {
    moe_tables(F, 256);
    const LAS int* T = (const LAS int*)(F.lds + TBL_OFF);
    pg8::MoeOrder S{T, nullptr, (const char*)F.act, (const char*)F.wd_t, 4, 1024, F.G, (int)blockIdx.x, false}; EpiBf16 E{F.y, DM, F.b_down, 1024};
    pg8::gemm_phase<EpiBf16, pg8::MoeOrder, false, true>(F.lds, DM, DM, S, E);
}

struct Args { const float* in[22]; float* out; unsigned char* ws; int ph_lo, ph_hi; };
__global__ void __launch_bounds__(NTHREADS, 2) fwd_kernel(Args args) {
    extern __shared__ __attribute__((aligned(16))) unsigned char lds[];
    Frame F;
    F.lds = (LAS unsigned char*)lds; F.MISC = (volatile LAS unsigned*)(F.lds + MISC_OFF);
    F.tid = threadIdx.x; F.lane = F.tid & 63; F.wave = __builtin_amdgcn_readfirstlane(F.tid >> 6);
    F.G = gridDim.x; { const int bx = blockIdx.x; F.vcu = (F.G % 8 == 0) ? (bx % 8) * (F.G / 8) + bx / 8 : bx; }
    unsigned char* ws = args.ws;
    F.ctl = (unsigned*)(ws + WS_CTL);
    F.x = args.in[0]; F.c = args.in[1]; F.ctx = args.in[2]; F.c_ctx = args.in[3]; F.w_mod = args.in[4]; F.b_mod = args.in[5];
    F.g_pre_mix = args.in[6]; F.g_post_mix = args.in[7]; F.g_pre_ffn = args.in[8]; F.g_post_ffn = args.in[9]; F.w_in = args.in[10];
    F.a_sink = args.in[11]; F.b_rpb = args.in[12]; F.w_branch_a = args.in[13]; F.w_branch_b = args.in[14]; F.w_out = args.in[15];
    F.w_router = args.in[16]; F.b_router = args.in[17]; F.w_gate_up = args.in[18]; F.b_gate_up = args.in[19]; F.w_down = args.in[20]; F.b_down = args.in[21];
    F.out = args.out;
    F.modx = (float*)(ws + WS_MODX); F.modc = (float*)(ws + WS_MODC); F.rope = (float*)(ws + WS_ROPE);
    F.win_t = (bf16*)(ws + WS_WIN); F.wa_t = (bf16*)(ws + WS_WA); F.wb_t = (bf16*)(ws + WS_WB); F.wout_t = (bf16*)(ws + WS_WOUT);
    F.wgu_t = (bf16*)(ws + WS_WGU); F.wd_t = (bf16*)(ws + WS_WD); F.xn = (bf16*)(ws + WS_XN); F.p = (bf16*)(ws + WS_P);
    F.yab = (bf16*)(ws + WS_YAB); F.merged = (bf16*)(ws + WS_MERGED); F.mix = (bf16*)(ws + WS_MIX); F.act = (bf16*)(ws + WS_ACT); F.y = (bf16*)(ws + WS_Y);
    F.tope = (int*)(ws + WS_TOPE); F.topp = (int*)(ws + WS_TOPP); F.topw = (float*)(ws + WS_TOPW); F.tok = (int*)(ws + WS_TOK);
    for (int u = F.tid; u < (LDS_BYTES - 131072) / 4; u += NTHREADS) ((LAS unsigned*)(F.lds + 131072))[u] = 0u;
    __syncthreads();
    XcdBarrier bar; bar.bar = F.ctl + CW_BAR; bar.x = 0; bar.st = nullptr;
    if (MK_N_LAUNCHES != PER_PHASE) bar = xcd_barrier_post(F.ctl + CW_BAR, F.MISC + 8);
    const int lo = args.ph_lo, hi = args.ph_hi;
#define IN(k) (lo <= (k) && (k) < hi)
#define SEAM(k) do { if (IN(k) && IN((k) + 1)) xcd_barrier(bar); } while (0)
    if (IN(0)) { p0_prologue(F); } SEAM(0);
    if (IN(1)) { p1_prenorm(F); } SEAM(1);
    if (IN(2)) { if (FAST_GEMM && F.G == 256) p2_inproj_fast(F); else p2_inproj_simple(F); } SEAM(2);
    if (IN(3)) { p3_attn_naive(F); } SEAM(3);
    if (IN(4)) { if (FAST_GEMM && F.G == 256) p4_merge_fast(F); else p4_merge_simple(F); } SEAM(4);
    if (IN(5)) { if (FAST_GEMM && F.G == 256) p5_outproj_fast(F); else p5_outproj_simple(F); } SEAM(5);
    if (IN(6)) { p6_row_router(F); } SEAM(6);
    if (IN(7)) { if (FAST_GEMM && F.G == 256) p7_gateup_fast(F); else p7_gateup_simple(F); } SEAM(7);
    if (IN(8)) { if (FAST_GEMM && F.G == 256) p8_down_fast(F); else p8_down_simple(F); } SEAM(8);
    if (IN(9)) { p9_final(F); }
#undef IN
#undef SEAM
}

extern "C" void kernel_launch(void* const* d_in, const int* in_sizes, int n_in, void* d_out, int out_size, void* d_ws, size_t ws_size, hipStream_t stream) {
    static int grid = 0;
    if (grid == 0) {
        if (n_in != 22 || out_size != MT * DM || ws_size < WS_END) { fprintf(stderr, "kernel_launch: unexpected problem (n_in %d, out %d, ws %zu); nothing launched\n", n_in, out_size, ws_size); grid = -1; return; }
        int dev = 0, cus = 0, per_cu = 0;
        if (hipGetDevice(&dev) != hipSuccess || hipDeviceGetAttribute(&cus, hipDeviceAttributeMultiprocessorCount, dev) != hipSuccess) { grid = -1; return; }
        if (hipFuncSetAttribute((const void*)fwd_kernel, hipFuncAttributeMaxDynamicSharedMemorySize, LDS_BYTES) != hipSuccess) { fprintf(stderr, "kernel_launch: hipFuncSetAttribute failed\n"); grid = -1; return; }
        if (hipOccupancyMaxActiveBlocksPerMultiprocessor(&per_cu, (const void*)fwd_kernel, NTHREADS, LDS_BYTES) != hipSuccess || per_cu < 1) { fprintf(stderr, "kernel_launch: occupancy query says %d blocks per CU\n", per_cu); grid = -1; (void)hipGetLastError(); return; }
        grid = cus;
    }
    if (grid < 0) return;
    if (hipMemsetAsync((char*)d_ws + WS_CTL, 0, CTL_ZERO_BYTES, stream) != hipSuccess) return;
    Args a{};
    for (int i = 0; i < 22; ++i) a.in[i] = (const float*)d_in[i];
    a.out = (float*)d_out; a.ws = (unsigned char*)d_ws;
    if (MK_N_LAUNCHES == 1) { a.ph_lo = 0; a.ph_hi = PER_PHASE; hipLaunchKernelGGL(fwd_kernel, dim3(grid), dim3(NTHREADS), LDS_BYTES, stream, a); }
    else for (int li = 0; li < PER_PHASE; ++li) { a.ph_lo = li; a.ph_hi = li + 1; hipLaunchKernelGGL(fwd_kernel, dim3(grid), dim3(NTHREADS), LDS_BYTES, stream, a); }
}
```

```cpp
#include <hip/hip_runtime.h>
#include <cstdio>
#include <cstdint>

#ifndef MK_N_LAUNCHES
#define MK_N_LAUNCHES 1
#endif

#ifndef FAST_ATTN
#define FAST_ATTN 1
#endif
#ifndef FAST_GEMM
#define FAST_GEMM 1
#endif
#define GAS __attribute__((address_space(1)))
#define LAS __attribute__((address_space(3)))
typedef unsigned short bf16;
typedef short bf16x8 __attribute__((ext_vector_type(8)));
typedef float f32x4 __attribute__((ext_vector_type(4)));
typedef unsigned u32x4 __attribute__((ext_vector_type(4)));
typedef unsigned u32x2 __attribute__((ext_vector_type(2)));
typedef GAS unsigned gu32;
typedef float f32x16 __attribute__((ext_vector_type(16)));
typedef short s16x4 __attribute__((ext_vector_type(4)));
constexpr float LOG2E = 1.4426950408889634f;
constexpr float QSCALE = 0.125f * LOG2E;
constexpr float NEGBIG = -30000.f;

constexpr int DM = 1024, NB = 8, SEQ = 2048, CTXL = 256, HD = 64;
constexpr int MT = NB * SEQ;
constexpr int MC = NB * CTXL;
constexpr int MA = MT + MC;
constexpr int INC = 4352;
constexpr int C_QA = 0, C_KA = 512, C_VA = 640, C_QB = 768, C_KB = 1280, C_VB = 1792, C_GA = 2304, C_GB = 3328;
constexpr int NE = 32, TOPK = 4, DE = 1024;
constexpr int SLOTS = MT * TOPK + NE * 256;
constexpr float NORM_EPS = 1e-6f;
constexpr int NWAVES = 8, NTHREADS = 512;
constexpr int PER_PHASE = 10;

constexpr size_t MiB = 1u << 20;
constexpr size_t WS_CTL = 0, CTL_ZERO_BYTES = 1 * MiB;
constexpr size_t WS_MODX = 1 * MiB;
constexpr size_t WS_MODC = WS_MODX + 8 * 6144 * 4;
constexpr size_t WS_ROPE = WS_MODC + 6144 * 4;
constexpr size_t WS_WIN = 2 * MiB;
constexpr size_t WS_WA = 11 * MiB;
constexpr size_t WS_WB = 12 * MiB;
constexpr size_t WS_WOUT = 13 * MiB;
constexpr size_t WS_TOPE = 15 * MiB;
constexpr size_t WS_TOPP = WS_TOPE + 256 * 1024;
constexpr size_t WS_TOPW = WS_TOPP + 256 * 1024;
constexpr size_t WS_WGU = 16 * MiB;
constexpr size_t WS_WD = 144 * MiB;
constexpr size_t WS_XN = 208 * MiB;
constexpr size_t WS_P = 244 * MiB;
constexpr size_t WS_ACT = WS_P;
constexpr size_t WS_YAB = 397 * MiB;
constexpr size_t WS_MERGED = 429 * MiB;
constexpr size_t WS_MIX = 461 * MiB;
constexpr size_t WS_TOK = 493 * MiB;
constexpr size_t WS_BTAB = 495 * MiB;
constexpr size_t WS_Y = 496 * MiB;
constexpr size_t WS_END = 640 * MiB;
static_assert(WS_ACT + (size_t)SLOTS * 1024 * 2 <= WS_YAB + 0 * MiB + 32 * MiB, "ACT overlays P (and may run into YAB, dead by then)");
static_assert(WS_Y + (size_t)SLOTS * 1024 * 2 <= WS_END, "ws map");
constexpr int CW_BAR = 4096;
constexpr int CW_CNT = 16384;

constexpr int LDS_BYTES = 147456;
constexpr int MISC_OFF = 131072 + 320;
constexpr int TBL_OFF = 131072 + 1024;
constexpr int TOKC_OFF = 131072 + 2048;

#define RLX_AGENT __ATOMIC_RELAXED, __HIP_MEMORY_SCOPE_AGENT
__device__ __forceinline__ unsigned f2bf(float f) { unsigned u = __builtin_bit_cast(unsigned, f); return (u + 0x7fffu + ((u >> 16) & 1u)) >> 16; }
__device__ __forceinline__ unsigned pk2(float lo, float hi) { return f2bf(lo) | (f2bf(hi) << 16); }
__device__ __forceinline__ float bf2f(unsigned b) { return __builtin_bit_cast(float, b << 16); }
__device__ __forceinline__ float wave_sum(float v) {
#pragma unroll
    for (int o = 1; o < 64; o <<= 1) v += __shfl_xor(v, o);
    return v;
}
__device__ __forceinline__ float sigmoidf_(float x) { return 1.f / (1.f + __expf(-x)); }

#define XB_TMO      128
#define XB_XCNT(j)  (256  + 64 * (j))
#define XB_XSUB(j)  (1280 + 64 * (j))
#define XB_XGEN(j)  (2304 + 64 * (j))
#define XB_TOP      3328
#define XB_TOPGEN   3392
#define XCD_BAR_WORDS 3456
#define XB_SPIN_CAP (1u << 18)
__device__ __forceinline__ unsigned xb_ld(unsigned* p)              { return __hip_atomic_load(p, __ATOMIC_RELAXED, __HIP_MEMORY_SCOPE_AGENT); }
__device__ __forceinline__ unsigned xb_add(unsigned* p, unsigned v) { return __hip_atomic_fetch_add(p, v, __ATOMIC_RELAXED, __HIP_MEMORY_SCOPE_AGENT); }
__device__ __forceinline__ unsigned xb_xcc_id() { return (unsigned)__builtin_amdgcn_s_getreg((3 << 11) | 20) & 0xFu; }
#define XB_SPIN(cond, bar) do { unsigned _sp = 0; while (cond) { __builtin_amdgcn_s_sleep(1); \
    if ((++_sp & 255u) == 0u) { if (xb_ld(&(bar)[XB_TMO])) break; if (_sp > XB_SPIN_CAP) { atomicAdd(&(bar)[XB_TMO], 1u); break; } } } } while (0)
struct XcdBarrier { unsigned* bar; unsigned x; volatile LAS unsigned* st; };
__device__ __forceinline__ XcdBarrier xcd_barrier_post(unsigned* bar, volatile LAS unsigned* st) {
    XcdBarrier b; b.bar = bar; b.x = xb_xcc_id(); b.st = st;
    if (threadIdx.x == 0) (void)xb_add(&bar[XB_XCNT(b.x)], 1u);
    return b;
}
__device__ __forceinline__ void xcd_barrier_complete(unsigned* bar, unsigned x, unsigned& nloc, unsigned& nx) {
    const unsigned G = gridDim.x * gridDim.y * gridDim.z;
    unsigned sum, cnt, mine, sp = 0u;
    for (;;) {
        sum = 0u; cnt = 0u; mine = 0u;
#pragma unroll
        for (unsigned j = 0; j < 16; ++j) { const unsigned c = xb_ld(&bar[XB_XCNT(j)]); sum += c; cnt += (c > 0u) ? 1u : 0u; mine = (j == x) ? c : mine; }
        if (sum == G) break;
        __builtin_amdgcn_s_sleep(1);
        if ((++sp & 255u) == 0u) { if (xb_ld(&bar[XB_TMO])) break; if (sp > XB_SPIN_CAP) { atomicAdd(&bar[XB_TMO], 1u); break; } }
    }
    nloc = mine > 0u ? mine : 1u; nx = cnt > 0u ? cnt : 1u;
}
__device__ __forceinline__ void xcd_barrier(const XcdBarrier& b) {
    asm volatile("s_waitcnt vmcnt(0)" ::: "memory");
    __syncthreads();
    if (threadIdx.x == 0) {
        unsigned* bar = b.bar;
        __builtin_amdgcn_s_waitcnt(0);
        unsigned nloc = b.st[0], nx = b.st[1];
        if (nloc == 0u) { xcd_barrier_complete(bar, b.x, nloc, nx); b.st[0] = nloc; b.st[1] = nx; }
        const unsigned old = xb_add(&bar[XB_XSUB(b.x)], 1u);
        const unsigned gen = old / nloc;
        if (old + 1u == (gen + 1u) * nloc) {
            __builtin_amdgcn_fence(__ATOMIC_RELEASE, "agent");
            asm volatile("s_waitcnt vmcnt(0)" ::: "memory");
            const unsigned og = xb_add(&bar[XB_TOP], 1u);
            const unsigned tg = og / nx;
            if (og + 1u == (tg + 1u) * nx) xb_add(&bar[XB_TOPGEN], 1u);
            else XB_SPIN(xb_ld(&bar[XB_TOPGEN]) == tg, bar);
            __builtin_amdgcn_fence(__ATOMIC_ACQUIRE, "agent");
            xb_add(&bar[XB_XGEN(b.x)], 1u);
            asm volatile("s_waitcnt vmcnt(0)" ::: "memory");
        } else {
            XB_SPIN(xb_ld(&bar[XB_XGEN(b.x)]) == gen, bar);
            __builtin_amdgcn_fence(__ATOMIC_ACQUIRE, "agent");
            asm volatile("s_waitcnt vmcnt(0)" ::: "memory");
        }
    }
    __syncthreads();
}

struct Frame {
    LAS unsigned char* lds;
    volatile LAS unsigned* MISC;
    unsigned* ctl;
    int tid, lane, wave, vcu, G;
    const float *x, *c, *ctx, *c_ctx, *w_mod, *b_mod, *g_pre_mix, *g_post_mix, *g_pre_ffn, *g_post_ffn, *w_in, *a_sink, *b_rpb,
                *w_branch_a, *w_branch_b, *w_out, *w_router, *b_router, *w_gate_up, *b_gate_up, *w_down, *b_down;
    float* out;
    float *modx, *modc, *rope;
    bf16 *win_t, *wa_t, *wb_t, *wout_t, *wgu_t, *wd_t, *xn, *p, *yab, *merged, *mix, *act, *y;
    int *tope, *topp, *tok; float* topw; bf16* btab;
};

template <int MODE> __device__ __forceinline__ int dst_row(int n) {
    if (MODE == 0) return n;
    const int up = n >> 10, j = n & 1023; return ((j >> 4) << 5) + (up << 4) + (j & 15);
}
template <int MODE> __device__ __forceinline__ void p0_transpose_item(const float* W, int K, int N, bf16* WT, LAS float* scr, int item, int lane) {
    const int nblk = N / 32, kb = item / nblk, nb = item % nblk, k0 = 64 * kb, n0 = 32 * nb;
#pragma unroll 8
    for (int i = 0; i < 32; ++i) { const int kk = 2 * i + (lane >> 5); scr[kk * 33 + (lane & 31)] = W[(size_t)(k0 + kk) * N + n0 + (lane & 31)]; }
    asm volatile("s_waitcnt lgkmcnt(0)" ::: "memory");
    const int c = lane & 7;
#pragma unroll
    for (int j = 0; j < 4; ++j) { const int n = (lane >> 3) + 8 * j; const LAS float* s = scr + (8 * c) * 33 + n;
        u32x4 o; o.x = pk2(s[0 * 33], s[1 * 33]); o.y = pk2(s[2 * 33], s[3 * 33]); o.z = pk2(s[4 * 33], s[5 * 33]); o.w = pk2(s[6 * 33], s[7 * 33]);
        *(u32x4*)(WT + (size_t)dst_row<MODE>(n0 + n) * K + k0 + 8 * c) = o; }
    asm volatile("s_waitcnt lgkmcnt(0)" ::: "memory");
}
__device__ __forceinline__ void p0_mod_item(Frame& F, int item) {
    LAS float* sil = (LAS float*)F.lds;
    LAS float* red = (LAS float*)(F.lds + 40960);
    for (int i = F.tid; i < 9 * 1024; i += NTHREADS) { const int r = i >> 10, k = i & 1023; const float cv = r < 8 ? F.c[r * 1024 + k] : F.c_ctx[k]; sil[i] = cv / (1.f + expf(-cv)); }
    __syncthreads();
    const int n0 = item * 32, cq = F.tid & 7, kl = F.tid >> 3;
    float acc[9][4];
#pragma unroll
    for (int r = 0; r < 9; ++r)
#pragma unroll
        for (int j = 0; j < 4; ++j) acc[r][j] = 0.f;
    for (int k = kl; k < 1024; k += 64) {
        const f32x4 w = *(const f32x4*)(F.w_mod + (size_t)k * 6144 + n0 + 4 * cq);
#pragma unroll
        for (int r = 0; r < 9; ++r) { const float s = sil[r * 1024 + k]; acc[r][0] += s * w.x; acc[r][1] += s * w.y; acc[r][2] += s * w.z; acc[r][3] += s * w.w; }
    }
#pragma unroll
    for (int r = 0; r < 9; ++r)
#pragma unroll
        for (int j = 0; j < 4; ++j) { float v = acc[r][j]; v += __shfl_xor(v, 8); v += __shfl_xor(v, 16); v += __shfl_xor(v, 32); if (F.lane < 8) red[(F.wave * 8 + cq) * 36 + r * 4 + j] = v; }
    __syncthreads();
    if (F.tid < 288) { const int q = F.tid / 36, rj = F.tid % 36, r = rj >> 2, j = rj & 3; float s = 0.f;
#pragma unroll
        for (int w = 0; w < 8; ++w) s += red[(w * 8 + q) * 36 + rj];
        const int n = n0 + 4 * q + j; s += F.b_mod[n];
        if (r < 8) F.modx[r * 6144 + n] = s; else F.modc[n] = s; }
    __syncthreads();
}
__device__ __forceinline__ void p0_prologue(Frame& F) {
    if (F.vcu < 192) p0_mod_item(F, F.vcu);
    if (F.vcu == 255 || (F.G < 256 && F.vcu == F.G - 1)) {
        for (int i = F.tid; i < 1024; i += NTHREADS) { const int pos = i >> 4, f = i & 15; const float inv = powf(10000.f, -(float)f / 16.f); const float ang = (float)pos * inv;
            F.rope[2 * i] = cosf(ang); F.rope[2 * i + 1] = sinf(ang); }
    }
    for (int idx = F.vcu * NTHREADS + F.tid; idx < 8 * 15 * 4 * 1024; idx += F.G * NTHREADS) {
        const int e = idx & 31, kk = (idx >> 5) & 31, kh = (idx >> 10) & 1, ch = (idx >> 11) & 1, hd = idx >> 12, dr = hd % 15, h = hd / 15;
        const int qc = 32 * ch + e, kc = 32 * kh + kk; int cs = qc - 8; cs = cs < 0 ? 0 : (cs > 48 ? 48 : cs);
        const bool valid = kc >= cs && kc < cs + 16;
        F.btab[idx] = (bf16)f2bf(valid ? F.b_rpb[h * 465 + dr * 31 + (kc - qc + 15)] * LOG2E : NEGBIG);
    }
    LAS float* scr = (LAS float*)(F.lds + F.wave * 16384);
    const int gw = F.vcu * NWAVES + F.wave, NGW = F.G * NWAVES;
    constexpr int I_IN = 16 * 136, I_A = 8 * 32, I_OUT = 16 * 32, I_GU = 16 * 64, I_D = 16 * 32;
    constexpr int NITEMS = I_IN + 2 * I_A + I_OUT + NE * I_GU + NE * I_D;
    for (int it = gw; it < NITEMS; it += NGW) {
        int r = it;
        if (r < I_IN) { p0_transpose_item<0>(F.w_in, 1024, INC, F.win_t, scr, r, F.lane); continue; } r -= I_IN;
        if (r < I_A) { p0_transpose_item<0>(F.w_branch_a, 512, 1024, F.wa_t, scr, r, F.lane); continue; } r -= I_A;
        if (r < I_A) { p0_transpose_item<0>(F.w_branch_b, 512, 1024, F.wb_t, scr, r, F.lane); continue; } r -= I_A;
        if (r < I_OUT) { p0_transpose_item<0>(F.w_out, 1024, 1024, F.wout_t, scr, r, F.lane); continue; } r -= I_OUT;
        if (r < NE * I_GU) { const int e = r / I_GU; p0_transpose_item<1>(F.w_gate_up + (size_t)e * 1024 * 2048, 1024, 2048, F.wgu_t + (size_t)e * 2048 * 1024, scr, r % I_GU, F.lane); continue; } r -= NE * I_GU;
        { const int e = r / I_D; p0_transpose_item<0>(F.w_down + (size_t)e * 1024 * 1024, 1024, 1024, F.wd_t + (size_t)e * 1024 * 1024, scr, r % I_D, F.lane); }
    }
}

__device__ __forceinline__ void p1_prenorm(Frame& F) {
    const int gw = F.vcu * NWAVES + F.wave, NGW = F.G * NWAVES;
    for (int m = gw; m < MA; m += NGW) {
        const float* xrow = m < MT ? F.x + (size_t)m * DM : F.ctx + (size_t)(m - MT) * DM;
        const float* sh = m < MT ? F.modx + (m / SEQ) * 6144 : F.modc;
        const float* sc = sh + 1024;
        f32x4 v[4]; float s = 0.f;
#pragma unroll
        for (int j = 0; j < 4; ++j) { v[j] = ((const f32x4*)xrow)[F.lane + 64 * j]; s += (v[j].x * v[j].x + v[j].y * v[j].y) + (v[j].z * v[j].z + v[j].w * v[j].w); }
        const float rs = 1.f / sqrtf(wave_sum(s) * (1.f / DM) + NORM_EPS);
        unsigned long long* o8 = (unsigned long long*)(F.xn + (size_t)m * DM) + F.lane;
#pragma unroll
        for (int j = 0; j < 4; ++j) { const int q = F.lane + 64 * j; const f32x4 g = ((const f32x4*)F.g_pre_mix)[q], a = ((const f32x4*)sh)[q], b = ((const f32x4*)sc)[q];
            const float h0 = v[j].x * rs * g.x * (1.f + b.x) + a.x, h1 = v[j].y * rs * g.y * (1.f + b.y) + a.y, h2 = v[j].z * rs * g.z * (1.f + b.z) + a.z, h3 = v[j].w * rs * g.w * (1.f + b.w) + a.w;
            o8[64 * j] = (unsigned long long)pk2(h0, h1) | ((unsigned long long)pk2(h2, h3) << 32); }
    }
}

__device__ __forceinline__ void wave_gemm_32x32(f32x4 (&acc)[2][2], const bf16* a0, const bf16* a1, const bf16* b0, const bf16* b1, int K, int fq) {
#pragma unroll 4
    for (int k = 0; k < K; k += 32) {
        const bf16x8 A0 = *(const bf16x8*)(a0 + k + 8 * fq), A1 = *(const bf16x8*)(a1 + k + 8 * fq);
        const bf16x8 B0 = *(const bf16x8*)(b0 + k + 8 * fq), B1 = *(const bf16x8*)(b1 + k + 8 * fq);
        acc[0][0] = __builtin_amdgcn_mfma_f32_16x16x32_bf16(B0, A0, acc[0][0], 0, 0, 0);
        acc[0][1] = __builtin_amdgcn_mfma_f32_16x16x32_bf16(B1, A0, acc[0][1], 0, 0, 0);
        acc[1][0] = __builtin_amdgcn_mfma_f32_16x16x32_bf16(B0, A1, acc[1][0], 0, 0, 0);
        acc[1][1] = __builtin_amdgcn_mfma_f32_16x16x32_bf16(B1, A1, acc[1][1], 0, 0, 0);
    }
}
__device__ __forceinline__ void zero_acc(f32x4 (&acc)[2][2]) {
#pragma unroll
    for (int i = 0; i < 2; ++i)
#pragma unroll
        for (int j = 0; j < 2; ++j) acc[i][j] = (f32x4){0.f, 0.f, 0.f, 0.f};
}
__device__ __forceinline__ void st4bf(bf16* p, float a, float b, float c, float d) { u32x2 w; w.x = pk2(a, b); w.y = pk2(c, d); *(u32x2*)p = w; }

__device__ __forceinline__ void p2_epilogue_tile(Frame& F, const f32x4 (&acc)[2][2], int r0, int c0, int fr, int fq) {
#pragma unroll
    for (int i = 0; i < 2; ++i) {
        const int row = r0 + 16 * i + fr; const bool is_ctx = row >= MT; const int t = row & (SEQ - 1);
        f32x4 v0 = acc[i][0], v1 = acc[i][1];
        if (c0 < C_VA) {
            if (!is_ctx) { const int axis = (c0 >> 5) & 1, pos = axis ? (t & 63) : (t >> 6); const float* rp = F.rope + (pos * 16 + 4 * fq) * 2;
#pragma unroll
                for (int e = 0; e < 4; ++e) { const float cs = rp[2 * e], sn = rp[2 * e + 1], x1 = v0[e], x2 = v1[e]; v0[e] = x1 * cs - x2 * sn; v1[e] = x2 * cs + x1 * sn; } }
            if (c0 < C_KA) { v0 = v0 * QSCALE; v1 = v1 * QSCALE; }
        } else if (c0 < C_QB) {
        } else if (c0 < C_KB) { v0 = v0 * QSCALE; v1 = v1 * QSCALE;
        } else if (c0 < C_GA) {
        } else {
#pragma unroll
            for (int e = 0; e < 4; ++e) { v0[e] = sigmoidf_(v0[e]); v1[e] = sigmoidf_(v1[e]); }
        }
        bf16* o = F.p + (size_t)row * INC + c0 + 4 * fq;
        st4bf(o, v0[0], v0[1], v0[2], v0[3]); st4bf(o + 16, v1[0], v1[1], v1[2], v1[3]);
    }
}
__device__ __forceinline__ void p2_inproj_simple(Frame& F) {
    const int gw = F.vcu * NWAVES + F.wave, NGW = F.G * NWAVES, fr = F.lane & 15, fq = F.lane >> 4;
    constexpr int NCT = INC / 32, NRT_L = MT / 32, NCT_C = (256 + 1024) / 32;
    constexpr int NT = NRT_L * NCT + (MC / 32) * NCT_C;
    for (int tl = gw; tl < NT; tl += NGW) {
        int r0, c0;
        if (tl < NRT_L * NCT) { r0 = (tl / NCT) * 32; c0 = (tl % NCT) * 32; }
        else { const int u = tl - NRT_L * NCT; r0 = MT + (u / NCT_C) * 32; const int cc = u % NCT_C; c0 = cc < 8 ? C_KA + cc * 32 : C_KB + (cc - 8) * 32; }
        f32x4 acc[2][2]; zero_acc(acc);
        const bf16* a0 = F.xn + (size_t)(r0 + fr) * DM; const bf16* b0 = F.win_t + (size_t)(c0 + fr) * DM;
        wave_gemm_32x32(acc, a0, a0 + 16 * DM, b0, b0 + 16 * DM, DM, fq);
        p2_epilogue_tile(F, acc, r0, c0, fr, fq);
    }
}

__device__ __forceinline__ void attn_key(const float (&q)[64], const bf16* kp, const bf16* vp, float bias, float& m, float& l, float (&o)[64]) {
    float s = bias;
#pragma unroll
    for (int d8 = 0; d8 < 8; ++d8) { const u32x4 kk = *(const u32x4*)(kp + 8 * d8);
        s += q[8 * d8 + 0] * bf2f(kk.x & 0xffffu) + q[8 * d8 + 1] * bf2f(kk.x >> 16) + q[8 * d8 + 2] * bf2f(kk.y & 0xffffu) + q[8 * d8 + 3] * bf2f(kk.y >> 16)
           + q[8 * d8 + 4] * bf2f(kk.z & 0xffffu) + q[8 * d8 + 5] * bf2f(kk.z >> 16) + q[8 * d8 + 6] * bf2f(kk.w & 0xffffu) + q[8 * d8 + 7] * bf2f(kk.w >> 16); }
    const float mn = fmaxf(m, s), al = exp2f(m - mn), pe = exp2f(s - mn);
    l = l * al + pe; m = mn;
#pragma unroll
    for (int d8 = 0; d8 < 8; ++d8) { const u32x4 vv = *(const u32x4*)(vp + 8 * d8);
        o[8 * d8 + 0] = o[8 * d8 + 0] * al + pe * bf2f(vv.x & 0xffffu); o[8 * d8 + 1] = o[8 * d8 + 1] * al + pe * bf2f(vv.x >> 16);
        o[8 * d8 + 2] = o[8 * d8 + 2] * al + pe * bf2f(vv.y & 0xffffu); o[8 * d8 + 3] = o[8 * d8 + 3] * al + pe * bf2f(vv.y >> 16);
        o[8 * d8 + 4] = o[8 * d8 + 4] * al + pe * bf2f(vv.z & 0xffffu); o[8 * d8 + 5] = o[8 * d8 + 5] * al + pe * bf2f(vv.z >> 16);
        o[8 * d8 + 6] = o[8 * d8 + 6] * al + pe * bf2f(vv.w & 0xffffu); o[8 * d8 + 7] = o[8 * d8 + 7] * al + pe * bf2f(vv.w >> 16); }
}
__device__ __forceinline__ void p3_attn_naive(Frame& F) {
    const int gt = F.vcu * NTHREADS + F.tid, NGT = F.G * NTHREADS;
    for (int w = gt; w < 2 * 8 * MT; w += NGT) {
        const int br = w / (8 * MT), h = (w / MT) & 7, t = w % MT, b = t / SEQ, tl = t % SEQ;
        float q[64], o[64];
        const bf16* qp = F.p + (size_t)t * INC + (br ? C_QB : C_QA) + h * 64;
#pragma unroll
        for (int d = 0; d < 64; ++d) { q[d] = bf2f(qp[d]); o[d] = 0.f; }
        float m, l;
        if (br == 0) {
            const int kvh = h >> 2; m = F.a_sink[h] * LOG2E; l = 1.f;
            const int j0 = tl - 128 < 0 ? 0 : tl - 128, j1 = tl + 128 > SEQ - 1 ? SEQ - 1 : tl + 128;
            for (int j = j0; j <= j1; ++j) { const bf16* rp = F.p + (size_t)(b * SEQ + j) * INC; attn_key(q, rp + C_KA + kvh * 64, rp + C_VA + kvh * 64, 0.f, m, l, o); }
            for (int j = 0; j < CTXL; ++j) { const bf16* rp = F.p + (size_t)(MT + b * CTXL + j) * INC; attn_key(q, rp + C_KA + kvh * 64, rp + C_VA + kvh * 64, 0.f, m, l, o); }
        } else {
            m = -1e30f; l = 0.f;
            const int r = tl >> 6, c = tl & 63; int rs = r - 4; rs = rs < 0 ? 0 : (rs > 24 ? 24 : rs); int cs = c - 8; cs = cs < 0 ? 0 : (cs > 48 ? 48 : cs);
            for (int kr = rs; kr < rs + 8; ++kr)
                for (int kc = cs; kc < cs + 16; ++kc) { const bf16* rp = F.p + (size_t)(b * SEQ + kr * 64 + kc) * INC;
                    int dc = kc - c; dc = dc < -15 ? -15 : (dc > 15 ? 15 : dc);
                    const float bias = F.b_rpb[h * 15 * 31 + (kr - r + 7) * 31 + dc + 15] * LOG2E;
                    attn_key(q, rp + C_KB + h * 64, rp + C_VB + h * 64, bias, m, l, o); }
            for (int j = 0; j < CTXL; ++j) { const bf16* rp = F.p + (size_t)(MT + b * CTXL + j) * INC; attn_key(q, rp + C_KB + h * 64, rp + C_VB + h * 64, 0.f, m, l, o); }
        }
        const float il = 1.f / l; bf16* op = F.yab + (size_t)t * DM + br * 512 + h * 64;
#pragma unroll
        for (int d = 0; d < 64; d += 4) st4bf(op + d, o[d] * il, o[d + 1] * il, o[d + 2] * il, o[d + 3] * il);
    }
}

__device__ __forceinline__ void p4_merge_simple(Frame& F) {
    const int gw = F.vcu * NWAVES + F.wave, NGW = F.G * NWAVES, fr = F.lane & 15, fq = F.lane >> 4;
    constexpr int NCT = DM / 32, NT = (MT / 32) * NCT;
    for (int tl = gw; tl < NT; tl += NGW) {
        const int r0 = (tl / NCT) * 32, c0 = (tl % NCT) * 32;
        f32x4 accA[2][2], accB[2][2]; zero_acc(accA); zero_acc(accB);
        const bf16* a0 = F.yab + (size_t)(r0 + fr) * DM;
        const bf16* ba = F.wa_t + (size_t)(c0 + fr) * 512; const bf16* bb = F.wb_t + (size_t)(c0 + fr) * 512;
        wave_gemm_32x32(accA, a0, a0 + 16 * DM, ba, ba + 16 * 512, 512, fq);
        wave_gemm_32x32(accB, a0 + 512, a0 + 512 + 16 * DM, bb, bb + 16 * 512, 512, fq);
#pragma unroll
        for (int i = 0; i < 2; ++i)
#pragma unroll
            for (int j = 0; j < 2; ++j) { const int row = r0 + 16 * i + fr, col = c0 + 16 * j + 4 * fq;
                const u32x2 ga = *(const u32x2*)(F.p + (size_t)row * INC + C_GA + col), gb = *(const u32x2*)(F.p + (size_t)row * INC + C_GB + col);
                const f32x4 a = accA[i][j], b = accB[i][j];
                st4bf(F.merged + (size_t)row * DM + col, bf2f(ga.x & 0xffffu) * a[0] + bf2f(gb.x & 0xffffu) * b[0], bf2f(ga.x >> 16) * a[1] + bf2f(gb.x >> 16) * b[1],
                      bf2f(ga.y & 0xffffu) * a[2] + bf2f(gb.y & 0xffffu) * b[2], bf2f(ga.y >> 16) * a[3] + bf2f(gb.y >> 16) * b[3]); }
    }
}
__device__ __forceinline__ void p5_outproj_simple(Frame& F) {
    const int gw = F.vcu * NWAVES + F.wave, NGW = F.G * NWAVES, fr = F.lane & 15, fq = F.lane >> 4;
    constexpr int NCT = DM / 32, NT = (MT / 32) * NCT;
    for (int tl = gw; tl < NT; tl += NGW) {
        const int r0 = (tl / NCT) * 32, c0 = (tl % NCT) * 32;
        f32x4 acc[2][2]; zero_acc(acc);
        const bf16* a0 = F.merged + (size_t)(r0 + fr) * DM; const bf16* b0 = F.wout_t + (size_t)(c0 + fr) * DM;
        wave_gemm_32x32(acc, a0, a0 + 16 * DM, b0, b0 + 16 * DM, DM, fq);
#pragma unroll
        for (int i = 0; i < 2; ++i)
#pragma unroll
            for (int j = 0; j < 2; ++j) { const f32x4 a = acc[i][j]; st4bf(F.mix + (size_t)(r0 + 16 * i + fr) * DM + c0 + 16 * j + 4 * fq, a[0], a[1], a[2], a[3]); }
    }
}

__device__ __forceinline__ void p6_row_router(Frame& F) {
    const int gw = F.vcu * NWAVES + F.wave, NGW = F.G * NWAVES;
    for (int m = gw; m < MT; m += NGW) {
        const float* md = F.modx + (m / SEQ) * 6144;
        f32x4 mx[4], xv[4]; float s = 0.f;
        const unsigned long long* mp = (const unsigned long long*)(F.mix + (size_t)m * DM) + F.lane;
#pragma unroll
        for (int j = 0; j < 4; ++j) { const unsigned long long w = mp[64 * j]; const unsigned lo = (unsigned)w, hi = (unsigned)(w >> 32);
            mx[j] = (f32x4){bf2f(lo & 0xffffu), bf2f(lo >> 16), bf2f(hi & 0xffffu), bf2f(hi >> 16)};
            s += (mx[j].x * mx[j].x + mx[j].y * mx[j].y) + (mx[j].z * mx[j].z + mx[j].w * mx[j].w); }
        const float r1 = 1.f / sqrtf(wave_sum(s) * (1.f / DM) + NORM_EPS);
        float s2 = 0.f;
#pragma unroll
        for (int j = 0; j < 4; ++j) { const int q = F.lane + 64 * j; const f32x4 x0 = ((const f32x4*)(F.x + (size_t)m * DM))[q], g = ((const f32x4*)F.g_post_mix)[q], g1 = ((const f32x4*)(md + 2048))[q];
            xv[j] = x0 + g1 * (mx[j] * r1 * g); ((f32x4*)(F.out + (size_t)m * DM))[q] = xv[j];
            s2 += (xv[j].x * xv[j].x + xv[j].y * xv[j].y) + (xv[j].z * xv[j].z + xv[j].w * xv[j].w); }
        const float r2 = 1.f / sqrtf(wave_sum(s2) * (1.f / DM) + NORM_EPS);
        unsigned long long* o8 = (unsigned long long*)(F.xn + (size_t)m * DM) + F.lane;
        float lg[32];
#pragma unroll
        for (int e = 0; e < 32; ++e) lg[e] = 0.f;
#pragma unroll
        for (int j = 0; j < 4; ++j) { const int q = F.lane + 64 * j; const f32x4 g = ((const f32x4*)F.g_pre_ffn)[q], sh = ((const f32x4*)(md + 3072))[q], sc = ((const f32x4*)(md + 4096))[q];
            const f32x4 h = xv[j] * r2 * g * (sc + 1.f) + sh;
            o8[64 * j] = (unsigned long long)pk2(h.x, h.y) | ((unsigned long long)pk2(h.z, h.w) << 32);
#pragma unroll
            for (int kk = 0; kk < 4; ++kk) { const float hv = h[kk]; const f32x4* wr = (const f32x4*)(F.w_router + (size_t)(4 * q + kk) * NE);
#pragma unroll
                for (int e4 = 0; e4 < 8; ++e4) { const f32x4 w = wr[e4]; lg[4 * e4] += hv * w.x; lg[4 * e4 + 1] += hv * w.y; lg[4 * e4 + 2] += hv * w.z; lg[4 * e4 + 3] += hv * w.w; } } }
#pragma unroll
        for (int e = 0; e < 32; ++e) lg[e] = wave_sum(lg[e]) + F.b_router[e];
        int ei[4]; float ev[4];
#pragma unroll
        for (int k = 0; k < 4; ++k) { float best = -INFINITY; int bi = 0;
#pragma unroll
            for (int e = 0; e < 32; ++e) if (lg[e] > best) { best = lg[e]; bi = e; }
#pragma unroll
            for (int e = 0; e < 32; ++e) if (e == bi) lg[e] = -INFINITY;
            ei[k] = bi; ev[k] = best; }
        const float w0 = 1.f, w1 = expf(ev[1] - ev[0]), w2 = expf(ev[2] - ev[0]), w3 = expf(ev[3] - ev[0]), inv = 1.f / (w0 + w1 + w2 + w3);
        if (F.lane < 4) { const int k = F.lane; const int e = k == 0 ? ei[0] : (k == 1 ? ei[1] : (k == 2 ? ei[2] : ei[3])); const float wv = (k == 0 ? w0 : (k == 1 ? w1 : (k == 2 ? w2 : w3))) * inv;
            const int pos = (int)__hip_atomic_fetch_add(F.ctl + CW_CNT + 64 * e, 1u, RLX_AGENT);
            F.tok[e * MT + pos] = m; F.tope[m * 4 + k] = e; F.topp[m * 4 + k] = pos; F.topw[m * 4 + k] = wv; }
    }
}

__device__ __forceinline__ void moe_tables(Frame& F, int RT) {
    LAS int* T = (LAS int*)(F.lds + TBL_OFF);
    if (F.tid == 0) { int pt = 0, pb = 0;
        for (int e = 0; e < NE; ++e) { const int n = (int)__hip_atomic_load(F.ctl + CW_CNT + 64 * e, RLX_AGENT); T[e] = n; T[32 + e] = pt; T[96 + e] = pb; pt += (n + RT - 1) / RT; pb += ((n + 255) / 256) * 256; }
        T[32 + NE] = pt; T[96 + NE] = pb; }
    __syncthreads();
}
__device__ __forceinline__ void p7_gateup_simple(Frame& F) {
    moe_tables(F, 32);
    const LAS int* T = (const LAS int*)(F.lds + TBL_OFF);
    const int gw = F.vcu * NWAVES + F.wave, NGW = F.G * NWAVES, fr = F.lane & 15, fq = F.lane >> 4;
    const int NT = T[32 + NE] * 64;
    for (int tl = gw; tl < NT; tl += NGW) {
        const int rt = tl >> 6, ct = tl & 63; int e = 0;
        while (e < NE - 1 && T[32 + e + 1] <= rt) ++e;
        const int n = T[e], p0 = (rt - T[32 + e]) * 32, base = T[96 + e];
        const int pa = p0 + fr, pb = p0 + 16 + fr;
        const int ta = F.tok[e * MT + (pa < n ? pa : 0)], tb = F.tok[e * MT + (pb < n ? pb : 0)];
        f32x4 acc[2][2]; zero_acc(acc);
        const bf16* b0 = F.wgu_t + ((size_t)e * 2048 + ct * 32 + fr) * DM;
        wave_gemm_32x32(acc, F.xn + (size_t)ta * DM, F.xn + (size_t)tb * DM, b0, b0 + 16 * DM, DM, fq);
        const int jg = ct * 16 + 4 * fq; const f32x4 bg = *(const f32x4*)(F.b_gate_up + (size_t)e * 2048 + jg), bu = *(const f32x4*)(F.b_gate_up + (size_t)e * 2048 + 1024 + jg);
#pragma unroll
        for (int i = 0; i < 2; ++i) { float r[4];
#pragma unroll
            for (int q = 0; q < 4; ++q) { float g = acc[i][0][q] + bg[q], u = acc[i][1][q] + bu[q]; g = fminf(g, 7.f); u = fminf(fmaxf(u, -7.f), 7.f); r[q] = (u + 1.f) * (g * sigmoidf_(1.702f * g)); }
            st4bf(F.act + (size_t)(base + p0 + 16 * i + fr) * DE + jg, r[0], r[1], r[2], r[3]); }
    }
}
__device__ __forceinline__ void p8_down_simple(Frame& F) {
    moe_tables(F, 32);
    const LAS int* T = (const LAS int*)(F.lds + TBL_OFF);
    const int gw = F.vcu * NWAVES + F.wave, NGW = F.G * NWAVES, fr = F.lane & 15, fq = F.lane >> 4;
    const int NT = T[32 + NE] * 32;
    for (int tl = gw; tl < NT; tl += NGW) {
        const int rt = tl >> 5, ct = tl & 31; int e = 0;
        while (e < NE - 1 && T[32 + e + 1] <= rt) ++e;
        const int p0 = (rt - T[32 + e]) * 32, base = T[96 + e];
        f32x4 acc[2][2]; zero_acc(acc);
        const bf16* a0 = F.act + (size_t)(base + p0 + fr) * DE; const bf16* b0 = F.wd_t + ((size_t)e * 1024 + ct * 32 + fr) * DE;
        wave_gemm_32x32(acc, a0, a0 + 16 * DE, b0, b0 + 16 * DE, DE, fq);
#pragma unroll
        for (int i = 0; i < 2; ++i)
#pragma unroll
            for (int j = 0; j < 2; ++j) { const int col = ct * 32 + 16 * j + 4 * fq; const f32x4 bd = *(const f32x4*)(F.b_down + (size_t)e * 1024 + col); const f32x4 a = acc[i][j] + bd;
                st4bf(F.y + (size_t)(base + p0 + 16 * i + fr) * DM + col, a[0], a[1], a[2], a[3]); }
    }
}
__device__ __forceinline__ void p9_final(Frame& F) {
    moe_tables(F, 32);
    const LAS int* T = (const LAS int*)(F.lds + TBL_OFF);
    const int gw = F.vcu * NWAVES + F.wave, NGW = F.G * NWAVES;
    for (int m = gw; m < MT; m += NGW) {
        const float* md = F.modx + (m / SEQ) * 6144;
        f32x4 f[4];
#pragma unroll
        for (int j = 0; j < 4; ++j) f[j] = (f32x4){0.f, 0.f, 0.f, 0.f};
#pragma unroll
        for (int k = 0; k < 4; ++k) { const int e = F.tope[m * 4 + k], pos = F.topp[m * 4 + k]; const float wv = F.topw[m * 4 + k];
            const unsigned long long* yp = (const unsigned long long*)(F.y + (size_t)(T[96 + e] + pos) * DM) + F.lane;
#pragma unroll
            for (int j = 0; j < 4; ++j) { const unsigned long long w = yp[64 * j]; const unsigned lo = (unsigned)w, hi = (unsigned)(w >> 32);
                f[j] += (f32x4){bf2f(lo & 0xffffu), bf2f(lo >> 16), bf2f(hi & 0xffffu), bf2f(hi >> 16)} * wv; } }
        float s = 0.f;
#pragma unroll
        for (int j = 0; j < 4; ++j) s += (f[j].x * f[j].x + f[j].y * f[j].y) + (f[j].z * f[j].z + f[j].w * f[j].w);
        const float rs = 1.f / sqrtf(wave_sum(s) * (1.f / DM) + NORM_EPS);
#pragma unroll
        for (int j = 0; j < 4; ++j) { const int q = F.lane + 64 * j; const f32x4 g = ((const f32x4*)F.g_post_ffn)[q], g2 = ((const f32x4*)(md + 5120))[q];
            f32x4* op = (f32x4*)(F.out + (size_t)m * DM) + q; *op = *op + g2 * (f[j] * rs * g); }
    }
}


namespace pg8 {
constexpr int BM = 256, BK = 64, HALF = 128, HTB = HALF * BK * 2, STAGE_BYTES = 8 * HTB, NXCD = 8, WGM = 8;
__device__ __forceinline__ int lds_byte(int r, int c) { const int st = (r >> 4) * 2 + (c >> 5), rr = r & 15, cc = c & 31, ob = rr * 64 + cc * 2; return st * 1024 + (ob ^ (((ob >> 9) & 1) << 5)); }
__device__ __forceinline__ void stage_rc(int b, int& R, int& C) { const int st = b / 1024, sb = b % 1024, swz = sb ^ (((sb >> 9) & 1) << 5); R = (st >> 1) * 16 + swz / 64; C = (st & 1) * 32 + (swz % 64) / 2; }
__device__ __forceinline__ int perm32(int rho) { const int n = rho >> 4, i = rho & 15; return 8 * (i >> 2) + 4 * n + (i & 3); }
struct Unit { int pm, pn, ex; };
__device__ __forceinline__ void map_tile(int L, int nM, int nN, int& pm, int& pn) {
    const int nwg = nM * nN; int wgid = L;
    { const int q = nwg / NXCD, r = nwg % NXCD, xcd = wgid % NXCD, off = wgid / NXCD; wgid = (xcd < r ? xcd * (q + 1) : r * (q + 1) + (xcd - r) * q) + off; }
    const int nig = WGM * nN, gid = wgid / nig, fm = gid * WGM, gsz = (nM - fm) < WGM ? (nM - fm) : WGM;
    pm = fm + ((wgid % nig) % gsz); pn = (wgid % nig) / gsz;
}
__device__ __forceinline__ unsigned cvt_pk_bf16(float lo, float hi) { unsigned r; asm volatile("v_cvt_pk_bf16_f32 %0, %1, %2" : "=v"(r) : "v"(lo), "v"(hi)); return r; }

template <class Epi, class Sched, bool GATHER, bool ALIGN_EPI>
__device__ __forceinline__ void gemm_phase(LAS unsigned char* lds, const int K, const int lda, const Sched& S, const Epi& E) {
    const int tid = threadIdx.x, wid = __builtin_amdgcn_readfirstlane(tid >> 6), lane = tid & 63, wr = wid >> 2, wc = wid & 3, fr = lane & 15, fq = lane >> 4;
    const int nt = K / BK;
    int RA[2], CA[2]; unsigned voffB[2];
#pragma unroll
    for (int i = 0; i < 2; ++i) { int R, C; stage_rc(tid * 16 + i * 8192, R, C); RA[i] = R; CA[i] = C; const int Rb = Epi::PERM ? ((R & ~31) + perm32(R & 31)) : R; voffB[i] = (unsigned)(Rb * K + C) * 2u; }
    const size_t kstep = (size_t)(BK * 2);
    const size_t hstepB = (size_t)HALF * K * 2;
    const unsigned ldsw = (unsigned)wid * 1024u;
    const int aoff = lds_byte(wr * 64 + fr, fq * 8), boff = lds_byte(wc * 32 + fr, fq * 8);
    unsigned OC[2][2], ON[2][2];
#define PG8_SETOFF(O, ui) do { _Pragma("unroll") for (int _h = 0; _h < 2; ++_h) _Pragma("unroll") for (int _i = 0; _i < 2; ++_i) { \
        if constexpr (GATHER) O[_h][_i] = (unsigned)S.tok_row((ui), _h * HALF + RA[_i]) * (unsigned)(lda * 2) + (unsigned)CA[_i] * 2u; \
        else O[_h][_i] = (unsigned)((_h * HALF + RA[_i]) * lda + CA[_i]) * 2u; } } while (0)
#define PG8_SA(b, h) (((b) * 2 + (h)) * HTB)
#define PG8_SB(b, h) ((4 + (b) * 2 + (h)) * HTB)
#define PG8_STAGEA(bufoff, gbase, O, h) do { _Pragma("unroll") for (int _i = 0; _i < 2; ++_i) \
        __builtin_amdgcn_global_load_lds((const unsigned*)((const char*)(gbase) + (O)[h][_i]), (LAS unsigned*)(lds + (bufoff) + ldsw + _i * 8192), 16, 0, 0); } while (0)
#define PG8_STAGEB(bufoff, gbase) do { _Pragma("unroll") for (int _i = 0; _i < 2; ++_i) \
        __builtin_amdgcn_global_load_lds((const unsigned*)((const char*)(gbase) + voffB[_i]), (LAS unsigned*)(lds + (bufoff) + ldsw + _i * 8192), 16, 0, 0); } while (0)
#define PG8_LDA(dst, b, h) do { _Pragma("unroll") for (int m = 0; m < 4; ++m) _Pragma("unroll") for (int k = 0; k < 2; ++k) dst[m][k] = *(const LAS bf16x8*)(lds + PG8_SA(b, h) + aoff + m * 2048 + k * 1024); } while (0)
#define PG8_LDB(dst, b, h) do { _Pragma("unroll") for (int n = 0; n < 2; ++n) _Pragma("unroll") for (int k = 0; k < 2; ++k) dst[n][k] = *(const LAS bf16x8*)(lds + PG8_SB(b, h) + boff + n * 2048 + k * 1024); } while (0)
#define PG8_MMA(ai, bj, At, Bt) do { __builtin_amdgcn_s_setprio(1); _Pragma("unroll") for (int m = 0; m < 4; ++m) _Pragma("unroll") for (int n = 0; n < 2; ++n) _Pragma("unroll") for (int k = 0; k < 2; ++k) \
        acc[ai][bj][m][n] = __builtin_amdgcn_mfma_f32_16x16x32_bf16(Bt[n][k], At[m][k], acc[ai][bj][m][n], 0, 0, 0); __builtin_amdgcn_s_setprio(0); } while (0)
#define PG8_WAIT_V(n) asm volatile("s_waitcnt vmcnt(" #n ")" ::: "memory")
#define PG8_WAIT_L(n) asm volatile("s_waitcnt lgkmcnt(" #n ")" ::: "memory")
#define PG8_BAR __builtin_amdgcn_s_barrier()
#define PG8_SCHED __builtin_amdgcn_sched_barrier(0)
    Unit cur, nxt; int ui = 0;
    if (!S.next(0, cur)) return;
    PG8_SETOFF(OC, 0);
    f32x4 acc[2][2][4][2];
#pragma unroll
    for (int a = 0; a < 2; ++a)
#pragma unroll
        for (int b = 0; b < 2; ++b)
#pragma unroll
            for (int m = 0; m < 4; ++m)
#pragma unroll
                for (int n = 0; n < 2; ++n) acc[a][b][m][n] = (f32x4){0.f, 0.f, 0.f, 0.f};
    bf16x8 At[4][2], B0[2][2], B1[2][2];
    const char* cA = S.a_base(cur); const char* cB = S.b_base(cur);
    PG8_STAGEB(PG8_SB(0, 0), cB); PG8_STAGEB(PG8_SB(0, 1), cB + hstepB); PG8_STAGEA(PG8_SA(0, 0), cA, OC, 0); PG8_STAGEA(PG8_SA(0, 1), cA, OC, 1);
    if (wr == 1) PG8_BAR;
    PG8_WAIT_V(2); PG8_BAR;
    PG8_STAGEB(PG8_SB(1, 0), cB + kstep); PG8_STAGEA(PG8_SA(1, 0), cA + kstep, OC, 0); PG8_STAGEB(PG8_SB(1, 1), cB + hstepB + kstep);
    PG8_WAIT_V(6); PG8_BAR;
    for (;;) {
        const bool has_next = S.next(ui + 1, nxt);
        const char* nA = has_next ? S.a_base(nxt) : cA; const char* nB = has_next ? S.b_base(nxt) : cB;
        if constexpr (GATHER) { if (has_next) { PG8_SETOFF(ON, ui + 1); } else {
#pragma unroll
            for (int h = 0; h < 2; ++h)
#pragma unroll
                for (int i = 0; i < 2; ++i) ON[h][i] = OC[h][i]; } }
        for (int t = 0; t < nt; t += 2) {
            const bool last = (t == nt - 2);
            const char* a1 = cA + (size_t)(t + 1) * kstep;
            const char* a2 = last ? nA : cA + (size_t)(t + 2) * kstep; const char* b2 = last ? nB : cB + (size_t)(t + 2) * kstep;
            const char* a3 = a2 + kstep; const char* b3 = b2 + kstep;
            unsigned O2[2][2];
#pragma unroll
            for (int h = 0; h < 2; ++h)
#pragma unroll
                for (int i = 0; i < 2; ++i) O2[h][i] = (GATHER && last) ? ON[h][i] : OC[h][i];
            PG8_LDB(B0, 0, 0); PG8_LDB(B1, 0, 1); PG8_SCHED; PG8_LDA(At, 0, 0); PG8_STAGEA(PG8_SA(1, 1), a1, OC, 1);
            PG8_WAIT_V(8); PG8_WAIT_L(0); PG8_BAR; PG8_MMA(0, 0, At, B0); PG8_MMA(0, 1, At, B1); PG8_BAR; PG8_SCHED;
            PG8_LDA(At, 0, 1); PG8_STAGEB(PG8_SB(0, 0), b2); PG8_STAGEB(PG8_SB(0, 1), b2 + hstepB); PG8_STAGEA(PG8_SA(0, 0), a2, O2, 0);
            PG8_WAIT_V(8); PG8_WAIT_L(0); PG8_BAR; PG8_MMA(1, 0, At, B0); PG8_MMA(1, 1, At, B1); PG8_BAR; PG8_SCHED;
            PG8_LDB(B0, 1, 0); PG8_LDB(B1, 1, 1); PG8_SCHED; PG8_LDA(At, 1, 0); PG8_STAGEA(PG8_SA(0, 1), a2, O2, 1);
            PG8_WAIT_V(8); PG8_WAIT_L(0); PG8_BAR; PG8_MMA(0, 0, At, B0); PG8_MMA(0, 1, At, B1); PG8_BAR; PG8_SCHED;
            PG8_LDA(At, 1, 1); PG8_STAGEB(PG8_SB(1, 0), b3); PG8_STAGEB(PG8_SB(1, 1), b3 + hstepB); PG8_STAGEA(PG8_SA(1, 0), a3, O2, 0);
            PG8_WAIT_V(8); PG8_WAIT_L(0); PG8_BAR; PG8_MMA(1, 0, At, B0); PG8_MMA(1, 1, At, B1); PG8_BAR; PG8_SCHED;
        }
        if constexpr (ALIGN_EPI) { if (wr == 0) PG8_BAR; }
        E(acc, cur, wr, wc, fr, fq);
        if (!has_next) break;
#pragma unroll
        for (int a = 0; a < 2; ++a)
#pragma unroll
            for (int b = 0; b < 2; ++b)
#pragma unroll
                for (int m = 0; m < 4; ++m)
#pragma unroll
                    for (int n = 0; n < 2; ++n) acc[a][b][m][n] = (f32x4){0.f, 0.f, 0.f, 0.f};
        cur = nxt; cA = nA; cB = nB; ++ui;
        if constexpr (GATHER) {
#pragma unroll
            for (int h = 0; h < 2; ++h)
#pragma unroll
                for (int i = 0; i < 2; ++i) OC[h][i] = ON[h][i]; }
        if constexpr (ALIGN_EPI) { if (wr == 1) PG8_BAR; }
    }
    PG8_WAIT_V(0);
    if constexpr (!ALIGN_EPI) { if (wr == 0) PG8_BAR; }
    PG8_BAR;
#undef PG8_SETOFF
#undef PG8_SA
#undef PG8_SB
#undef PG8_STAGEA
#undef PG8_STAGEB
#undef PG8_LDA
#undef PG8_LDB
#undef PG8_MMA
#undef PG8_WAIT_V
#undef PG8_WAIT_L
#undef PG8_BAR
#undef PG8_SCHED
}

struct InProjOrder {
    const char* A; const char* Bt; int G, c;
    __device__ __forceinline__ bool next(int i, Unit& u) const {
        const int L = i * G + c; if (L >= 64 * 17 + 40) return false; u.ex = 0;
        if (L < 64 * 17) { map_tile(L, 64, 17, u.pm, u.pn); return true; }
        const int uu = L - 64 * 17; u.pm = 64 + (uu & 7); const int j = uu >> 3; u.pn = j == 0 ? 2 : 4 + j; return true;
    }
    __device__ __forceinline__ const char* a_base(const Unit& u) const { return A + (size_t)u.pm * (256 * DM * 2); }
    __device__ __forceinline__ const char* b_base(const Unit& u) const { return Bt + (size_t)u.pn * (256 * DM * 2); }
};
struct MergeOrder {
    const char* yab; const char* wa; const char* wb; int G, c;
    __device__ __forceinline__ bool next(int i, Unit& u) const { const int L = i * G + c; if (L >= 512) return false; u.ex = L >> 8; map_tile(L & 255, 64, 4, u.pm, u.pn); return true; }
    __device__ __forceinline__ const char* a_base(const Unit& u) const { return yab + ((size_t)u.pm * 256 * DM + u.ex * 512) * 2; }
    __device__ __forceinline__ const char* b_base(const Unit& u) const { return (u.ex ? wb : wa) + (size_t)u.pn * (256 * 512 * 2); }
};
struct DenseOrder {
    const char* A; const char* Bt; int nM, nN, G, c;
    __device__ __forceinline__ bool next(int i, Unit& u) const { const int L = i * G + c; if (L >= nM * nN) return false; u.ex = 0; map_tile(L, nM, nN, u.pm, u.pn); return true; }
    __device__ __forceinline__ const char* a_base(const Unit& u) const { return A + (size_t)u.pm * (256 * DM * 2); }
    __device__ __forceinline__ const char* b_base(const Unit& u) const { return Bt + (size_t)u.pn * (256 * DM * 2); }
};
struct MoeOrder {
    const LAS int* T; const LAS int* tokc; const char* A; const char* Bt; int nN, brows, G, c; bool gather;
    __device__ __forceinline__ bool next(int i, Unit& u) const {
        const int Tm = T[32 + NE]; const int L = i * G + c; if (L >= Tm * nN) return false;
        map_tile(L, Tm, nN, u.pm, u.pn); int e = 0; while (e < NE - 1 && T[32 + e + 1] <= u.pm) ++e; u.ex = e; return true;
    }
    __device__ __forceinline__ const char* a_base(const Unit& u) const { return gather ? A : A + (size_t)u.pm * (256 * DM * 2); }
    __device__ __forceinline__ const char* b_base(const Unit& u) const { return Bt + ((size_t)u.ex * brows + (size_t)u.pn * 256) * (DM * 2); }
    __device__ __forceinline__ int tok_row(int ui, int r) const { return tokc[ui * 256 + r]; }
};
}

__device__ __forceinline__ void inproj_xform(const float* rope, int row, int c0, int fq, f32x4& v0, f32x4& v1) {
    const bool is_ctx = row >= MT; const int t = row & (SEQ - 1);
    if (c0 < C_VA) {
        if (!is_ctx) { const int axis = (c0 >> 5) & 1, pos = axis ? (t & 63) : (t >> 6); const float* rp = rope + (pos * 16 + 4 * fq) * 2;
            const f32x4 r0 = *(const f32x4*)rp, r1 = *(const f32x4*)(rp + 4);
            const float cs[4] = {r0[0], r0[2], r1[0], r1[2]}, sn[4] = {r0[1], r0[3], r1[1], r1[3]};
#pragma unroll
            for (int e = 0; e < 4; ++e) { const float x1 = v0[e], x2 = v1[e]; v0[e] = x1 * cs[e] - x2 * sn[e]; v1[e] = x2 * cs[e] + x1 * sn[e]; } }
        if (c0 < C_KA) { v0 = v0 * QSCALE; v1 = v1 * QSCALE; }
    } else if (c0 < C_QB) {
    } else if (c0 < C_KB) { v0 = v0 * QSCALE; v1 = v1 * QSCALE;
    } else if (c0 < C_GA) {
    } else {
#pragma unroll
        for (int e = 0; e < 4; ++e) { v0[e] = sigmoidf_(v0[e]); v1[e] = sigmoidf_(v1[e]); }
    }
}
struct EpiInProj {
    static constexpr bool PERM = false;
    bf16* P; const float* rope;
    __device__ __forceinline__ void operator()(const f32x4 (&acc)[2][2][4][2], const pg8::Unit& u, int wr, int wc, int fr, int fq) const {
#pragma unroll
        for (int ai = 0; ai < 2; ++ai)
#pragma unroll
            for (int m = 0; m < 4; ++m) { const int row = u.pm * 256 + ai * 128 + wr * 64 + m * 16 + fr;
#pragma unroll
                for (int bj = 0; bj < 2; ++bj) { const int c0 = u.pn * 256 + bj * 128 + wc * 32; f32x4 v0 = acc[ai][bj][m][0], v1 = acc[ai][bj][m][1];
                    inproj_xform(rope, row, c0, fq, v0, v1);
                    bf16* o = P + (size_t)row * INC + c0 + 4 * fq; u32x2 w0, w1; w0.x = pg8::cvt_pk_bf16(v0[0], v0[1]); w0.y = pg8::cvt_pk_bf16(v0[2], v0[3]); w1.x = pg8::cvt_pk_bf16(v1[0], v1[1]); w1.y = pg8::cvt_pk_bf16(v1[2], v1[3]);
                    *(u32x2*)o = w0; *(u32x2*)(o + 16) = w1; } }
    }
};
struct EpiMerge {
    static constexpr bool PERM = true;
    bf16* merged; const bf16* P;
    __device__ __forceinline__ void operator()(const f32x4 (&acc)[2][2][4][2], const pg8::Unit& u, int wr, int wc, int fr, int fq) const {
        const int gcol = u.ex ? C_GB : C_GA;
#pragma unroll
        for (int ai = 0; ai < 2; ++ai)
#pragma unroll
            for (int m = 0; m < 4; ++m) { const int row = u.pm * 256 + ai * 128 + wr * 64 + m * 16 + fr;
#pragma unroll
                for (int bj = 0; bj < 2; ++bj) { const int col0 = u.pn * 256 + bj * 128 + wc * 32 + 8 * fq; const f32x4 v0 = acc[ai][bj][m][0], v1 = acc[ai][bj][m][1];
                    const u32x4 g = *(const u32x4*)(P + (size_t)row * INC + gcol + col0); bf16* op = merged + (size_t)row * DM + col0;
                    float r[8] = {bf2f(g.x & 0xffffu) * v0[0], bf2f(g.x >> 16) * v0[1], bf2f(g.y & 0xffffu) * v0[2], bf2f(g.y >> 16) * v0[3],
                                  bf2f(g.z & 0xffffu) * v1[0], bf2f(g.z >> 16) * v1[1], bf2f(g.w & 0xffffu) * v1[2], bf2f(g.w >> 16) * v1[3]};
                    if (u.ex) { const u32x4 o = *(const u32x4*)op; r[0] += bf2f(o.x & 0xffffu); r[1] += bf2f(o.x >> 16); r[2] += bf2f(o.y & 0xffffu); r[3] += bf2f(o.y >> 16);
                        r[4] += bf2f(o.z & 0xffffu); r[5] += bf2f(o.z >> 16); r[6] += bf2f(o.w & 0xffffu); r[7] += bf2f(o.w >> 16); }
                    u32x4 w; w.x = pg8::cvt_pk_bf16(r[0], r[1]); w.y = pg8::cvt_pk_bf16(r[2], r[3]); w.z = pg8::cvt_pk_bf16(r[4], r[5]); w.w = pg8::cvt_pk_bf16(r[6], r[7]);
                    *(u32x4*)op = w; } }
    }
};
struct EpiBf16 {
    static constexpr bool PERM = true;
    bf16* O; int ldc; const float* bias; int bias_estride;
    __device__ __forceinline__ void operator()(const f32x4 (&acc)[2][2][4][2], const pg8::Unit& u, int wr, int wc, int fr, int fq) const {
        const int row0 = u.pm * 256 + wr * 64 + fr, col0 = u.pn * 256 + wc * 32 + 8 * fq;
        f32x4 bv[2][2];
#pragma unroll
        for (int bj = 0; bj < 2; ++bj)
#pragma unroll
            for (int n = 0; n < 2; ++n) bv[bj][n] = bias ? *(const f32x4*)(bias + (size_t)u.ex * bias_estride + col0 + bj * 128 + 4 * n) : (f32x4){0.f, 0.f, 0.f, 0.f};
#pragma unroll
        for (int ai = 0; ai < 2; ++ai)
#pragma unroll
            for (int m = 0; m < 4; ++m) { bf16* rowp = O + (size_t)(row0 + ai * 128 + m * 16) * ldc + col0;
#pragma unroll
                for (int bj = 0; bj < 2; ++bj) { const f32x4 v0 = acc[ai][bj][m][0] + bv[bj][0], v1 = acc[ai][bj][m][1] + bv[bj][1];
                    u32x4 w; w.x = pg8::cvt_pk_bf16(v0[0], v0[1]); w.y = pg8::cvt_pk_bf16(v0[2], v0[3]); w.z = pg8::cvt_pk_bf16(v1[0], v1[1]); w.w = pg8::cvt_pk_bf16(v1[2], v1[3]);
                    *(u32x4*)(rowp + bj * 128) = w; } }
    }
};
struct EpiGateUp {
    static constexpr bool PERM = false;
    bf16* act; const float* bgu;
    __device__ __forceinline__ void operator()(const f32x4 (&acc)[2][2][4][2], const pg8::Unit& u, int wr, int wc, int fr, int fq) const {
        f32x4 bg[2], bu[2]; int jg[2];
#pragma unroll
        for (int bj = 0; bj < 2; ++bj) { jg[bj] = 16 * (u.pn * 8 + bj * 4 + wc) + 4 * fq; bg[bj] = *(const f32x4*)(bgu + (size_t)u.ex * 2048 + jg[bj]); bu[bj] = *(const f32x4*)(bgu + (size_t)u.ex * 2048 + 1024 + jg[bj]); }
#pragma unroll
        for (int ai = 0; ai < 2; ++ai)
#pragma unroll
            for (int m = 0; m < 4; ++m) { const int row = u.pm * 256 + ai * 128 + wr * 64 + m * 16 + fr;
#pragma unroll
                for (int bj = 0; bj < 2; ++bj) { float r[4];
#pragma unroll
                    for (int q = 0; q < 4; ++q) { float g = acc[ai][bj][m][0][q] + bg[bj][q], uu = acc[ai][bj][m][1][q] + bu[bj][q]; g = fminf(g, 7.f); uu = fminf(fmaxf(uu, -7.f), 7.f); r[q] = (uu + 1.f) * (g * sigmoidf_(1.702f * g)); }
                    u32x2 w; w.x = pg8::cvt_pk_bf16(r[0], r[1]); w.y = pg8::cvt_pk_bf16(r[2], r[3]); *(u32x2*)(act + (size_t)row * DE + jg[bj]) = w; } }
    }
};


constexpr int AT_KTILE = 32 * 144, AT_VTILE = 4096, AT_KBUF = 2 * AT_KTILE, AT_VBUF = 2 * AT_VTILE;
constexpr float AT_THR = 6.f;
typedef short v4i16_t __attribute__((ext_vector_type(4)));
__device__ __forceinline__ s16x4 vtr(const LAS unsigned char* p) { return __builtin_bit_cast(s16x4, __builtin_amdgcn_ds_read_tr16_b64_v4i16((LAS v4i16_t*)p)); }
__device__ __forceinline__ void attn_tile(const LAS unsigned char* kt, const LAS unsigned char* vt, const bf16x8 (&qf)[4], const bool use_bias, const bf16x8 (&oh)[2], const bf16* btab,
                                          const bool masked, const int mlo, const int mhi, f32x16& o0, f32x16& o1, float& m, float& l, const int r, const int hh, const int vrd) {
    f32x16 s;
#pragma unroll
    for (int i = 0; i < 16; ++i) s[i] = 0.f;
    const LAS unsigned char* kp = kt + r * 144 + hh * 16;
#pragma unroll
    for (int ds = 0; ds < 4; ++ds) { const bf16x8 kf = *(const LAS bf16x8*)(kp + ds * 32); s = __builtin_amdgcn_mfma_f32_32x32x16_bf16(kf, qf[ds], s, 0, 0, 0); }
    if (use_bias) {
#pragma unroll
        for (int sp = 0; sp < 2; ++sp) { const bf16x8 bk = *(const bf16x8*)(btab + r * 32 + sp * 16 + hh * 8); s = __builtin_amdgcn_mfma_f32_32x32x16_bf16(bk, oh[sp], s, 0, 0, 0); }
    }
    if (masked) {
#pragma unroll
        for (int i = 0; i < 16; ++i) { const int kk = (i & 3) + 8 * (i >> 2) + 4 * hh; s[i] = (kk >= mlo && kk <= mhi) ? s[i] : NEGBIG; }
    }
    float mx = fmaxf(s[0], s[1]);
#pragma unroll
    for (int i = 2; i < 16; ++i) mx = fmaxf(mx, s[i]);
    { auto rr = __builtin_amdgcn_permlane32_swap(__float_as_uint(mx), __float_as_uint(mx), false, false); mx = fmaxf(__uint_as_float(rr[0]), __uint_as_float(rr[1])); }
    if (!__all(mx - m <= AT_THR)) { const float mn = fmaxf(m, mx), al = __builtin_amdgcn_exp2f(m - mn); o0 = o0 * al; o1 = o1 * al; l *= al; m = mn; }
    float p[16], ls = 0.f;
#pragma unroll
    for (int i = 0; i < 16; ++i) { p[i] = __builtin_amdgcn_exp2f(s[i] - m); ls += p[i]; }
    l += ls;
    bf16x8 pb[2];
#pragma unroll
    for (int sk = 0; sk < 2; ++sk) { u32x4 w; w.x = pg8::cvt_pk_bf16(p[8 * sk + 0], p[8 * sk + 1]); w.y = pg8::cvt_pk_bf16(p[8 * sk + 2], p[8 * sk + 3]); w.z = pg8::cvt_pk_bf16(p[8 * sk + 4], p[8 * sk + 5]); w.w = pg8::cvt_pk_bf16(p[8 * sk + 6], p[8 * sk + 7]);
        pb[sk] = __builtin_bit_cast(bf16x8, w); }
    const LAS unsigned char* vp = vt + vrd;
#pragma unroll
    for (int sk = 0; sk < 2; ++sk) {
        const s16x4 l0 = vtr(vp + sk * 1024), h0 = vtr(vp + sk * 1024 + 512), l1 = vtr(vp + 2048 + sk * 1024), h1 = vtr(vp + 2048 + sk * 1024 + 512);
        const bf16x8 v0 = (bf16x8){l0[0], l0[1], l0[2], l0[3], h0[0], h0[1], h0[2], h0[3]}, v1 = (bf16x8){l1[0], l1[1], l1[2], l1[3], h1[0], h1[1], h1[2], h1[3]};
        o0 = __builtin_amdgcn_mfma_f32_32x32x16_bf16(v0, pb[sk], o0, 0, 0, 0);
        o1 = __builtin_amdgcn_mfma_f32_32x32x16_bf16(v1, pb[sk], o1, 0, 0, 0);
    }
}
template <int BR> __device__ __forceinline__ void attn_unit(Frame& F, const int unit) {
    const int lane = F.lane, r = lane & 31, hh = lane >> 5, wave = F.wave;
    const int b = unit >> 6;
    int h, kcol, vcol, qcol, t0, nloc, loc_row0, qr = 0, ch = 0, kr_lo = 0, rsq = 0, q0w = 0, k0_first = 0;
    if (BR == 0) { const int kvh = (unit >> 5) & 1, blk = unit & 31, q0 = blk * 64; h = kvh * 4 + (wave >> 1); q0w = q0 + 32 * (wave & 1);
        kcol = C_KA + kvh * 64; vcol = C_VA + kvh * 64; qcol = C_QA + h * 64; t0 = b * SEQ + q0w;
        const int cl_lo = q0 < 128 ? (128 - q0) / 64 : 0; int cl_hi = 4; while (q0 - 128 + 64 * cl_hi > SEQ - 64) --cl_hi;
        nloc = cl_hi - cl_lo + 1; k0_first = q0 - 128 + 64 * cl_lo; loc_row0 = b * SEQ + k0_first;
    } else { h = (unit >> 3) & 7; const int g = unit & 7; qr = 4 * g + (wave >> 1); ch = wave & 1; kcol = C_KB + h * 64; vcol = C_VB + h * 64; qcol = C_QB + h * 64; t0 = b * SEQ + qr * 64 + 32 * ch;
        kr_lo = 4 * g - 4; kr_lo = kr_lo < 0 ? 0 : (kr_lo > 24 ? 24 : kr_lo); int kr_hi = 4 * g + 3 - 4; kr_hi = (kr_hi < 0 ? 0 : (kr_hi > 24 ? 24 : kr_hi)) + 7;
        nloc = kr_hi - kr_lo + 1; loc_row0 = b * SEQ + kr_lo * 64; rsq = qr - 4; rsq = rsq < 0 ? 0 : (rsq > 24 ? 24 : rsq); }
    const int nch = 4 + nloc;
    bf16x8 qf[4];
    { const bf16* qp = F.p + (size_t)(t0 + r) * INC + qcol + hh * 8;
#pragma unroll
      for (int ds = 0; ds < 4; ++ds) qf[ds] = *(const bf16x8*)(qp + 16 * ds); }
    bf16x8 oh[2];
#pragma unroll
    for (int sp = 0; sp < 2; ++sp)
#pragma unroll
        for (int j = 0; j < 8; ++j) oh[sp][j] = (BR == 1 && (16 * sp + 8 * hh + j) == r) ? (short)0x3F80 : (short)0;
    f32x16 o0, o1;
#pragma unroll
    for (int i = 0; i < 16; ++i) { o0[i] = 0.f; o1[i] = 0.f; }
    float m, l;
    if (BR == 0) { m = F.a_sink[h] * LOG2E; l = hh == 0 ? 1.f : 0.f; } else { m = -1e30f; l = 0.f; }
    const int vrd = hh * 256 + ((lane >> 2) & 3) * 64 + ((lane >> 4) & 1) * 32 + (lane & 3) * 8;
    const int skey = F.tid >> 3, sc = F.tid & 7;
    const int kw = (skey >> 5) * AT_KTILE + (skey & 31) * 144 + sc * 16, vw = 2 * AT_KBUF + (skey >> 5) * AT_VTILE + (sc >> 2) * 2048 + (skey & 31) * 64 + (sc & 3) * 16;
#define AT_CHROW(i) ((i) < 4 ? MT + b * CTXL + 64 * (i) : loc_row0 + 64 * ((i) - 4))
    u32x4 kreg, vreg;
    { const bf16* g = F.p + (size_t)(AT_CHROW(0) + skey) * INC; kreg = *(const u32x4*)(g + kcol + sc * 8); vreg = *(const u32x4*)(g + vcol + sc * 8); }
    *(LAS u32x4*)(F.lds + kw) = kreg; *(LAS u32x4*)(F.lds + vw) = vreg;
    __syncthreads();
    for (int i = 0; i < nch; ++i) {
        if (i + 1 < nch) { const bf16* g = F.p + (size_t)(AT_CHROW(i + 1) + skey) * INC; kreg = *(const u32x4*)(g + kcol + sc * 8); vreg = *(const u32x4*)(g + vcol + sc * 8); }
        const LAS unsigned char* kb = F.lds + (i & 1) * AT_KBUF; const LAS unsigned char* vb = F.lds + 2 * AT_KBUF + (i & 1) * AT_VBUF;
#pragma unroll
        for (int tl = 0; tl < 2; ++tl) {
            bool use_bias = false, masked = false; int mlo = -1, mhi = 99; const bf16* bt = F.btab;
            if (i >= 4) {
                if (BR == 0) { const int delta = k0_first + 64 * (i - 4) + 32 * tl - q0w; if (delta < -128 || delta > 128) continue;
                    if (delta == -128) { masked = true; mlo = r; } else if (delta == 128) { masked = true; mhi = r; } }
                else { const int kr = kr_lo + (i - 4); if (kr < rsq || kr >= rsq + 8) continue; use_bias = true; bt = F.btab + (size_t)((((h * 15 + (kr - qr + 7)) * 2 + ch) * 2 + tl) * 1024); }
            }
            attn_tile(kb + tl * AT_KTILE, vb + tl * AT_VTILE, qf, use_bias, oh, bt, masked, mlo, mhi, o0, o1, m, l, r, hh, vrd);
        }
        if (i + 1 < nch) { *(LAS u32x4*)(F.lds + ((i + 1) & 1) * AT_KBUF + kw) = kreg; *(LAS u32x4*)(F.lds + ((i + 1) & 1) * AT_VBUF + vw) = vreg; }
        __syncthreads();
    }
#undef AT_CHROW
    { auto rr = __builtin_amdgcn_permlane32_swap(__float_as_uint(l), __float_as_uint(l), false, false); l = __uint_as_float(rr[0]) + __uint_as_float(rr[1]); }
    const float inv = 1.f / l;
    bf16* op = F.yab + (size_t)(t0 + r) * DM + BR * 512 + h * 64 + 4 * hh;
#pragma unroll
    for (int g4 = 0; g4 < 4; ++g4) { u32x2 w0, w1; w0.x = pg8::cvt_pk_bf16(o0[4 * g4] * inv, o0[4 * g4 + 1] * inv); w0.y = pg8::cvt_pk_bf16(o0[4 * g4 + 2] * inv, o0[4 * g4 + 3] * inv);
        w1.x = pg8::cvt_pk_bf16(o1[4 * g4] * inv, o1[4 * g4 + 1] * inv); w1.y = pg8::cvt_pk_bf16(o1[4 * g4 + 2] * inv, o1[4 * g4 + 3] * inv);
        *(u32x2*)(op + 8 * g4) = w0; *(u32x2*)(op + 32 + 8 * g4) = w1; }
}
__device__ __forceinline__ void p3_attn_fast(Frame& F) {
    for (int u = F.vcu; u < 1024; u += F.G) { if (u < 512) attn_unit<0>(F, u); else attn_unit<1>(F, u - 512); }
}

__device__ __forceinline__ void p2_inproj_fast(Frame& F) {
    pg8::InProjOrder S{(const char*)F.xn, (const char*)F.win_t, F.G, (int)blockIdx.x}; EpiInProj E{F.p, F.rope};
    pg8::gemm_phase<EpiInProj, pg8::InProjOrder, false, true>(F.lds, DM, DM, S, E);
}
__device__ __forceinline__ void p4_merge_fast(Frame& F) {
    pg8::MergeOrder S{(const char*)F.yab, (const char*)F.wa_t, (const char*)F.wb_t, F.G, (int)blockIdx.x}; EpiMerge E{F.merged, F.p};
    pg8::gemm_phase<EpiMerge, pg8::MergeOrder, false, true>(F.lds, 512, DM, S, E);
}
__device__ __forceinline__ void p5_outproj_fast(Frame& F) {
    pg8::DenseOrder S{(const char*)F.merged, (const char*)F.wout_t, 64, 4, F.G, (int)blockIdx.x}; EpiBf16 E{F.mix, DM, nullptr, 0};
    pg8::gemm_phase<EpiBf16, pg8::DenseOrder, false, true>(F.lds, DM, DM, S, E);
}
__device__ __forceinline__ void p7_gateup_fast(Frame& F) {
    moe_tables(F, 256);
    const LAS int* T = (const LAS int*)(F.lds + TBL_OFF); LAS int* tokc = (LAS int*)(F.lds + TOKC_OFF);
    pg8::MoeOrder S{T, tokc, (const char*)F.xn, (const char*)F.wgu_t, 8, 2048, F.G, (int)blockIdx.x, true};
    for (int i = 0; i < 9; ++i) { pg8::Unit u; if (!S.next(i, u)) break;
        if (F.tid < 256) { const int e = u.ex, pos = (u.pm - T[32 + e]) * 256 + F.tid, n = T[e]; tokc[i * 256 + F.tid] = F.tok[e * MT + (pos < n ? pos : 0)]; } }
    __syncthreads();
    EpiGateUp E{F.act, F.b_gate_up};
    pg8::gemm_phase<EpiGateUp, pg8::MoeOrder, true, true>(F.lds, DM, DM, S, E);
}
__device__ __forceinline__ void p8_down_fast(Frame& F) {
    moe_tables(F, 256);
    const LAS int* T = (const LAS int*)(F.lds + TBL_OFF);
    pg8::MoeOrder S{T, nullptr, (const char*)F.act, (const char*)F.wd_t, 4, 1024, F.G, (int)blockIdx.x, false}; EpiBf16 E{F.y, DM, F.b_down, 1024};
    pg8::gemm_phase<EpiBf16, pg8::MoeOrder, false, true>(F.lds, DM, DM, S, E);
}

struct Args { const float* in[22]; float* out; unsigned char* ws; int ph_lo, ph_hi; };
__global__ void __launch_bounds__(NTHREADS, 2) fwd_kernel(Args args) {
    extern __shared__ __attribute__((aligned(16))) unsigned char lds[];
    Frame F;
    F.lds = (LAS unsigned char*)lds; F.MISC = (volatile LAS unsigned*)(F.lds + MISC_OFF);
    F.tid = threadIdx.x; F.lane = F.tid & 63; F.wave = __builtin_amdgcn_readfirstlane(F.tid >> 6);
    F.G = gridDim.x; { const int bx = blockIdx.x; F.vcu = (F.G % 8 == 0) ? (bx % 8) * (F.G / 8) + bx / 8 : bx; }
    unsigned char* ws = args.ws;
    F.ctl = (unsigned*)(ws + WS_CTL);
    F.x = args.in[0]; F.c = args.in[1]; F.ctx = args.in[2]; F.c_ctx = args.in[3]; F.w_mod = args.in[4]; F.b_mod = args.in[5];
    F.g_pre_mix = args.in[6]; F.g_post_mix = args.in[7]; F.g_pre_ffn = args.in[8]; F.g_post_ffn = args.in[9]; F.w_in = args.in[10];
    F.a_sink = args.in[11]; F.b_rpb = args.in[12]; F.w_branch_a = args.in[13]; F.w_branch_b = args.in[14]; F.w_out = args.in[15];
    F.w_router = args.in[16]; F.b_router = args.in[17]; F.w_gate_up = args.in[18]; F.b_gate_up = args.in[19]; F.w_down = args.in[20]; F.b_down = args.in[21];
    F.out = args.out;
    F.modx = (float*)(ws + WS_MODX); F.modc = (float*)(ws + WS_MODC); F.rope = (float*)(ws + WS_ROPE);
    F.win_t = (bf16*)(ws + WS_WIN); F.wa_t = (bf16*)(ws + WS_WA); F.wb_t = (bf16*)(ws + WS_WB); F.wout_t = (bf16*)(ws + WS_WOUT);
    F.wgu_t = (bf16*)(ws + WS_WGU); F.wd_t = (bf16*)(ws + WS_WD); F.xn = (bf16*)(ws + WS_XN); F.p = (bf16*)(ws + WS_P);
    F.yab = (bf16*)(ws + WS_YAB); F.merged = (bf16*)(ws + WS_MERGED); F.mix = (bf16*)(ws + WS_MIX); F.act = (bf16*)(ws + WS_ACT); F.y = (bf16*)(ws + WS_Y);
    F.tope = (int*)(ws + WS_TOPE); F.topp = (int*)(ws + WS_TOPP); F.topw = (float*)(ws + WS_TOPW); F.tok = (int*)(ws + WS_TOK); F.btab = (bf16*)(ws + WS_BTAB);
    for (int u = F.tid; u < (LDS_BYTES - 131072) / 4; u += NTHREADS) ((LAS unsigned*)(F.lds + 131072))[u] = 0u;
    __syncthreads();
    XcdBarrier bar; bar.bar = F.ctl + CW_BAR; bar.x = 0; bar.st = nullptr;
    if (MK_N_LAUNCHES != PER_PHASE) bar = xcd_barrier_post(F.ctl + CW_BAR, F.MISC + 8);
    const int lo = args.ph_lo, hi = args.ph_hi;
#define IN(k) (lo <= (k) && (k) < hi)
#define SEAM(k) do { if (IN(k) && IN((k) + 1)) xcd_barrier(bar); } while (0)
    if (IN(0)) { p0_prologue(F); } SEAM(0);
    if (IN(1)) { p1_prenorm(F); } SEAM(1);
    if (IN(2)) { if (FAST_GEMM && F.G == 256) p2_inproj_fast(F); else p2_inproj_simple(F); } SEAM(2);
    if (IN(3)) { if (FAST_ATTN) p3_attn_fast(F); else p3_attn_naive(F); } SEAM(3);
    if (IN(4)) { if (FAST_GEMM && F.G == 256) p4_merge_fast(F); else p4_merge_simple(F); } SEAM(4);
    if (IN(5)) { if (FAST_GEMM && F.G == 256) p5_outproj_fast(F); else p5_outproj_simple(F); } SEAM(5);
    if (IN(6)) { p6_row_router(F); } SEAM(6);
    if (IN(7)) { if (FAST_GEMM && F.G == 256) p7_gateup_fast(F); else p7_gateup_simple(F); } SEAM(7);
    if (IN(8)) { if (FAST_GEMM && F.G == 256) p8_down_fast(F); else p8_down_simple(F); } SEAM(8);
    if (IN(9)) { p9_final(F); }
#undef IN
#undef SEAM
}

extern "C" void kernel_launch(void* const* d_in, const int* in_sizes, int n_in, void* d_out, int out_size, void* d_ws, size_t ws_size, hipStream_t stream) {
    static int grid = 0;
    if (grid == 0) {
        if (n_in != 22 || out_size != MT * DM || ws_size < WS_END) { fprintf(stderr, "kernel_launch: unexpected problem (n_in %d, out %d, ws %zu); nothing launched\n", n_in, out_size, ws_size); grid = -1; return; }
        int dev = 0, cus = 0, per_cu = 0;
        if (hipGetDevice(&dev) != hipSuccess || hipDeviceGetAttribute(&cus, hipDeviceAttributeMultiprocessorCount, dev) != hipSuccess) { grid = -1; return; }
        if (hipFuncSetAttribute((const void*)fwd_kernel, hipFuncAttributeMaxDynamicSharedMemorySize, LDS_BYTES) != hipSuccess) { fprintf(stderr, "kernel_launch: hipFuncSetAttribute failed\n"); grid = -1; return; }
        if (hipOccupancyMaxActiveBlocksPerMultiprocessor(&per_cu, (const void*)fwd_kernel, NTHREADS, LDS_BYTES) != hipSuccess || per_cu < 1) { fprintf(stderr, "kernel_launch: occupancy query says %d blocks per CU\n", per_cu); grid = -1; (void)hipGetLastError(); return; }
        grid = cus;
    }
    if (grid < 0) return;
    if (hipMemsetAsync((char*)d_ws + WS_CTL, 0, CTL_ZERO_BYTES, stream) != hipSuccess) return;
    Args a{};
    for (int i = 0; i < 22; ++i) a.in[i] = (const float*)d_in[i];
    a.out = (float*)d_out; a.ws = (unsigned char*)d_ws;
    if (MK_N_LAUNCHES == 1) { a.ph_lo = 0; a.ph_hi = PER_PHASE; hipLaunchKernelGGL(fwd_kernel, dim3(grid), dim3(NTHREADS), LDS_BYTES, stream, a); }
    else for (int li = 0; li < PER_PHASE; ++li) { a.ph_lo = li; a.ph_hi = li + 1; hipLaunchKernelGGL(fwd_kernel, dim3(grid), dim3(NTHREADS), LDS_BYTES, stream, a); }
}
```
